# Optimizing an MI355X kernel written in HIP

```python
import math
import jax, jax.numpy as jnp
from jax import lax
import numpy as np

D_MODEL = 1024
BATCH = 16
SEQ = 2048
DEPTH = 4

MEM_LEN = 256
MIX_WIDTH = D_MODEL
SSM_WIDTH = D_MODEL // 4
SSM_GROUP = 16
SSM_GROUPS = SSM_WIDTH // SSM_GROUP
SSM_STATE = 64
SSM_DT_MIN = 1e-3
SSM_DT_MAX = 1e-1
RET_HEADS = 4
RET_HEAD_DIM = D_MODEL // 16
RET_WIDTH = RET_HEADS * RET_HEAD_DIM
RET_CHUNK = 128
ROPE_BASE = 10000.0
SB_HEADS = 8
SB_HEAD_DIM = D_MODEL // 16
SB_WIDTH = SB_HEADS * SB_HEAD_DIM
SB_BLOCK = 128
IN_COLS = SSM_WIDTH + 4 * RET_WIDTH + 3 * SB_WIDTH
CROSS_HEADS = 4
CROSS_HEAD_DIM = D_MODEL // CROSS_HEADS
D_FF = ((8 * D_MODEL // 3 + 255) // 256) * 256
N_EXPERTS = 8
TOP_K = 2
N_DENSE = (DEPTH + 1) // 2
N_MOE = DEPTH // 2
NORM_EPS = 1e-6
GN_EPS = 1e-6

kernel_name = "hybrid_s5_retention_stickbreak_moe"

F32 = jnp.float32


def rms_norm(x, w):
    xf = x.astype(F32)
    y = xf * lax.rsqrt(jnp.mean(xf * xf, axis=-1, keepdims=True) + NORM_EPS)
    return (y * w.astype(F32)).astype(x.dtype)


def _complex_linear_combine(e1, e2):
    a1r, a1i, b1r, b1i = e1
    a2r, a2i, b2r, b2i = e2
    ar = a1r * a2r - a1i * a2i
    ai = a1r * a2i + a1i * a2r
    br = a2r * b1r - a2i * b1i + b2r
    bi = a2r * b1i + a2i * b1r + b2i
    return (ar, ai, br, bi)


def s5_mixer(u, lam_re, lam_im, b_re, b_im, c_re, c_im, d_skip, log_dt, w_glu):
    dtype = u.dtype
    bsz, seq, _ = u.shape
    uf = u.astype(F32)
    ug = uf.reshape(bsz, seq, SSM_GROUPS, SSM_GROUP)
    lr = lam_re.astype(F32)
    li = lam_im.astype(F32)
    dt = jnp.exp(log_dt.astype(F32))[:, None]
    mag = jnp.exp(lr * dt)
    a_re = mag * jnp.cos(li * dt)
    a_im = mag * jnp.sin(li * dt)
    denom = lr * lr + li * li
    nr = a_re - 1.0
    z_re = (nr * lr + a_im * li) / denom
    z_im = (a_im * lr - nr * li) / denom
    br = b_re.astype(F32)
    bi = b_im.astype(F32)
    bb_re = z_re[..., None] * br - z_im[..., None] * bi
    bb_im = z_re[..., None] * bi + z_im[..., None] * br
    bu_re = jnp.einsum('bsgh,gph->bsgp', ug, bb_re)
    bu_im = jnp.einsum('bsgh,gph->bsgp', ug, bb_im)
    a_re_s = jnp.broadcast_to(a_re, (1, seq) + a_re.shape)
    a_im_s = jnp.broadcast_to(a_im, (1, seq) + a_im.shape)
    _, _, x_re, x_im = lax.associative_scan(
        _complex_linear_combine, (a_re_s, a_im_s, bu_re, bu_im), axis=1)
    y = (jnp.einsum('bsgp,ghp->bsgh', x_re, c_re.astype(F32))
         - jnp.einsum('bsgp,ghp->bsgh', x_im, c_im.astype(F32)))
    y = y.reshape(bsz, seq, SSM_WIDTH) + d_skip.astype(F32) * uf
    g = jax.nn.gelu(y)
    out = g * jax.nn.sigmoid(g @ w_glu.astype(F32))
    return out.astype(dtype)


def rotary(x, pos):
    half = x.shape[-1] // 2
    inv_freq = ROPE_BASE ** (-jnp.arange(half, dtype=F32) / half)
    ang = (pos[:, None] * inv_freq[None, :])[None, :, None, :]
    cos, sin = jnp.cos(ang), jnp.sin(ang)
    x1, x2 = x[..., :half], x[..., half:]
    return jnp.concatenate([x1 * cos - x2 * sin, x1 * sin + x2 * cos], axis=-1)


def retention_mixer(q, k, v, g, gn_w):
    dtype = q.dtype
    bsz, seq, _ = q.shape
    H, dh = RET_HEADS, RET_HEAD_DIM
    pos = jnp.arange(seq, dtype=F32)
    qh = rotary(q.reshape(bsz, seq, H, dh).astype(F32), pos)
    kh = rotary(k.reshape(bsz, seq, H, dh).astype(F32), pos) * (dh ** -0.5)
    vh = v.reshape(bsz, seq, H, dh).astype(F32)
    n_chunks = seq // RET_CHUNK

    def to_chunks(t):
        return t.reshape(bsz, n_chunks, RET_CHUNK, H, dh).transpose(1, 0, 3, 2, 4)

    log_gamma = jnp.log1p(-(2.0 ** (-5.0 - jnp.arange(H, dtype=F32))))
    idx = jnp.arange(RET_CHUNK, dtype=F32)
    rel = idx[:, None] - idx[None, :]
    intra = jnp.where(rel >= 0,
                      jnp.exp(log_gamma[:, None, None] * jnp.maximum(rel, 0.0)),
                      0.0)
    xi = jnp.exp(log_gamma[:, None] * (idx + 1.0))[..., None]
    zeta = jnp.exp(log_gamma[:, None] * (RET_CHUNK - 1.0 - idx))[..., None]
    chunk_decay = jnp.exp(log_gamma * RET_CHUNK)[:, None, None]

    def step(state, qkv):
        qc, kc, vc = qkv
        scores = jnp.einsum('bhnd,bhmd->bhnm', qc, kc) * intra
        out = (jnp.einsum('bhnm,bhme->bhne', scores, vc)
               + jnp.einsum('bhnd,bhde->bhne', qc, state) * xi)
        state = chunk_decay * state + jnp.einsum('bhmd,bhme->bhde', kc * zeta, vc)
        return state, out

    state0 = jnp.zeros((bsz, H, dh, dh), F32)
    _, o = lax.scan(step, state0, (to_chunks(qh), to_chunks(kh), to_chunks(vh)))
    o = o.transpose(1, 0, 3, 2, 4).reshape(bsz, seq, H, dh)
    mu = jnp.mean(o, axis=-1, keepdims=True)
    var = jnp.mean(jnp.square(o - mu), axis=-1, keepdims=True)
    o = ((o - mu) * lax.rsqrt(var + GN_EPS)).reshape(bsz, seq, RET_WIDTH) * gn_w.astype(F32)
    out = jax.nn.silu(g.astype(F32)) * o
    return out.astype(dtype)


def stick_breaking_mixer(q, k, v):
    dtype = q.dtype
    bsz, seq, _ = q.shape
    H, dh = SB_HEADS, SB_HEAD_DIM
    qh = q.reshape(bsz, seq, H, dh).transpose(0, 2, 1, 3).astype(F32) * (dh ** -0.5)
    kh = k.reshape(bsz, seq, H, dh).transpose(0, 2, 1, 3).astype(F32)
    vh = v.reshape(bsz, seq, H, dh).transpose(0, 2, 1, 3).astype(F32)
    n_blocks = seq // SB_BLOCK
    q_blocks = qh.reshape(bsz, H, n_blocks, SB_BLOCK, dh).transpose(2, 0, 1, 3, 4)
    starts = jnp.arange(n_blocks, dtype=jnp.int32) * SB_BLOCK
    k_pos = jnp.arange(seq, dtype=jnp.int32)

    def block(args):
        qb, t0 = args
        z = jnp.einsum('bhqd,bhkd->bhqk', qb, kh)
        q_pos = t0 + jnp.arange(SB_BLOCK, dtype=jnp.int32)
        mask = k_pos[None, :] < q_pos[:, None]
        log_fail = jnp.where(mask, jax.nn.log_sigmoid(-z), 0.0)
        after = lax.cumsum(log_fail, axis=3, reverse=True) - log_fail
        w = jnp.where(mask, jnp.exp(jax.nn.log_sigmoid(z) + after), 0.0)
        return jnp.einsum('bhqk,bhkd->bhqd', w, vh)

    o = lax.map(block, (q_blocks, starts))
    o = o.transpose(1, 0, 3, 2, 4).reshape(bsz, seq, SB_WIDTH)
    return o.astype(dtype)


def cross_attention(h, mem_n, w_q, w_kv, w_o):
    bsz, seq, _ = h.shape
    m = mem_n.shape[1]
    q = (h @ w_q).reshape(bsz, seq, CROSS_HEADS, CROSS_HEAD_DIM)
    kv = (mem_n @ w_kv).reshape(bsz, m, 2, CROSS_HEADS, CROSS_HEAD_DIM)
    k, v = kv[:, :, 0], kv[:, :, 1]
    s = jnp.einsum('bshd,bmhd->bhsm', q, k).astype(F32) * (CROSS_HEAD_DIM ** -0.5)
    p = jax.nn.softmax(s, axis=-1).astype(v.dtype)
    o = jnp.einsum('bhsm,bmhd->bshd', p, v).reshape(bsz, seq, D_MODEL)
    return o @ w_o


def swiglu(x, w_gu, w_down):
    gate, up = jnp.split(x @ w_gu, 2, axis=-1)
    return (jax.nn.silu(gate) * up) @ w_down


def moe_swiglu(x, w_router, w_gu, w_down):
    bsz, seq, d = x.shape
    t = x.reshape(bsz * seq, d)
    logits = (t @ w_router).astype(F32)
    top_logits, top_idx = lax.top_k(logits, TOP_K)
    top_w = jax.nn.softmax(top_logits, axis=-1)
    gates = jnp.sum(jax.nn.one_hot(top_idx, N_EXPERTS, dtype=F32) * top_w[..., None], axis=1)
    out = jnp.zeros_like(t)
    for e in range(N_EXPERTS):
        out = out + gates[:, e:e + 1].astype(t.dtype) * swiglu(t, w_gu[e], w_down[e])
    return out.reshape(bsz, seq, d)


def setup_inputs(seed: int = 0) -> dict:
    key = jax.random.key(seed)
    ks = iter(jax.random.split(key, 32))

    def normal(shape, scale):
        return jax.random.normal(next(ks), shape, F32) * scale

    def gain(shape):
        return 1.0 + normal(shape, 0.02)

    n_idx = jnp.arange(SSM_STATE, dtype=F32)
    lam_re = -0.5 + normal((DEPTH, SSM_GROUPS, SSM_STATE), 0.005)
    lam_im = math.pi * n_idx[None, None, :] + normal((DEPTH, SSM_GROUPS, SSM_STATE), 0.005)
    log_dt = jax.random.uniform(next(ks), (DEPTH, SSM_GROUPS), F32,
                                math.log(SSM_DT_MIN), math.log(SSM_DT_MAX))
    return {
        "x": normal((BATCH, SEQ, D_MODEL), 1.0),
        "mem": normal((BATCH, MEM_LEN, D_MODEL), 1.0),
        "mix_norm_w": gain((DEPTH, D_MODEL)),
        "w_in": normal((DEPTH, D_MODEL, IN_COLS), D_MODEL ** -0.5),
        "ssm_lambda_re": lam_re,
        "ssm_lambda_im": lam_im,
        "ssm_b_re": normal((DEPTH, SSM_GROUPS, SSM_STATE, SSM_GROUP), (2 * SSM_GROUP) ** -0.5),
        "ssm_b_im": normal((DEPTH, SSM_GROUPS, SSM_STATE, SSM_GROUP), (2 * SSM_GROUP) ** -0.5),
        "ssm_c_re": normal((DEPTH, SSM_GROUPS, SSM_GROUP, SSM_STATE), SSM_STATE ** -0.5),
        "ssm_c_im": normal((DEPTH, SSM_GROUPS, SSM_GROUP, SSM_STATE), SSM_STATE ** -0.5),
        "ssm_d": normal((DEPTH, SSM_WIDTH), 1.0),
        "ssm_log_dt": log_dt,
        "ssm_w_glu": normal((DEPTH, SSM_WIDTH, SSM_WIDTH), SSM_WIDTH ** -0.5),
        "mix_out_gain": gain((DEPTH, MIX_WIDTH)),
        "w_out": normal((DEPTH, MIX_WIDTH, D_MODEL), MIX_WIDTH ** -0.5),
        "cross_norm_w": gain((DEPTH, D_MODEL)),
        "mem_norm_w": gain((D_MODEL,)),
        "w_cross_q": normal((DEPTH, D_MODEL, D_MODEL), D_MODEL ** -0.5),
        "w_cross_kv": normal((DEPTH, D_MODEL, 2 * D_MODEL), D_MODEL ** -0.5),
        "w_cross_o": normal((DEPTH, D_MODEL, D_MODEL), D_MODEL ** -0.5),
        "ffn_norm_w": gain((DEPTH, D_MODEL)),
        "w_dense_gu": normal((N_DENSE, D_MODEL, 2 * D_FF), D_MODEL ** -0.5),
        "w_dense_down": normal((N_DENSE, D_FF, D_MODEL), D_FF ** -0.5),
        "w_router": normal((N_MOE, D_MODEL, N_EXPERTS), D_MODEL ** -0.5),
        "w_expert_gu": normal((N_MOE, N_EXPERTS, D_MODEL, 2 * D_FF), D_MODEL ** -0.5),
        "w_expert_down": normal((N_MOE, N_EXPERTS, D_FF, D_MODEL), D_FF ** -0.5),
        "final_norm_w": gain((D_MODEL,)),
    }


def reference(x, mem, mix_norm_w, w_in, ssm_lambda_re, ssm_lambda_im, ssm_b_re, ssm_b_im,
              ssm_c_re, ssm_c_im, ssm_d, ssm_log_dt, ssm_w_glu, mix_out_gain, w_out,
              cross_norm_w, mem_norm_w, w_cross_q, w_cross_kv, w_cross_o, ffn_norm_w,
              w_dense_gu, w_dense_down, w_router, w_expert_gu, w_expert_down, final_norm_w):
    o_ret = SSM_WIDTH
    o_sb = SSM_WIDTH + 4 * RET_WIDTH
    mem_n = rms_norm(mem, mem_norm_w)
    h = x
    for i in range(DEPTH):
        proj = rms_norm(h, mix_norm_w[i]) @ w_in[i]
        u_ssm = proj[..., :o_ret]
        r_q = proj[..., o_ret:o_ret + RET_WIDTH]
        r_k = proj[..., o_ret + RET_WIDTH:o_ret + 2 * RET_WIDTH]
        r_v = proj[..., o_ret + 2 * RET_WIDTH:o_ret + 3 * RET_WIDTH]
        r_g = proj[..., o_ret + 3 * RET_WIDTH:o_sb]
        s_q = proj[..., o_sb:o_sb + SB_WIDTH]
        s_k = proj[..., o_sb + SB_WIDTH:o_sb + 2 * SB_WIDTH]
        s_v = proj[..., o_sb + 2 * SB_WIDTH:o_sb + 3 * SB_WIDTH]
        gain_i = mix_out_gain[i]
        y_a = s5_mixer(u_ssm, ssm_lambda_re[i], ssm_lambda_im[i], ssm_b_re[i], ssm_b_im[i],
                       ssm_c_re[i], ssm_c_im[i], ssm_d[i], ssm_log_dt[i], ssm_w_glu[i])
        y_b = retention_mixer(r_q, r_k, r_v, r_g, gain_i[SSM_WIDTH:SSM_WIDTH + RET_WIDTH])
        y_c = stick_breaking_mixer(s_q, s_k, s_v)
        y = jnp.concatenate([
            rms_norm(y_a, gain_i[:SSM_WIDTH]),
            y_b,
            rms_norm(y_c, gain_i[SSM_WIDTH + RET_WIDTH:]),
        ], axis=-1)
        h = h + y @ w_out[i]
        h = h + cross_attention(rms_norm(h, cross_norm_w[i]), mem_n,
                                w_cross_q[i], w_cross_kv[i], w_cross_o[i])
        hn = rms_norm(h, ffn_norm_w[i])
        if i % 2 == 0:
            h = h + swiglu(hn, w_dense_gu[i // 2], w_dense_down[i // 2])
        else:
            h = h + moe_swiglu(hn, w_router[i // 2], w_expert_gu[i // 2], w_expert_down[i // 2])
    return rms_norm(h, final_norm_w)
```

```cpp
#include <hip/hip_runtime.h>
#include <cstdio>
#include <cstdint>
#ifndef MK_MULTI
#define MK_MULTI 0
#endif
namespace pg8 {
#define PG8_LAS __attribute__((address_space(3)))
typedef unsigned short bf16_t;
typedef short bf16x8 __attribute__((ext_vector_type(8)));
typedef float f32x4 __attribute__((ext_vector_type(4)));
typedef unsigned u32x4 __attribute__((ext_vector_type(4)));
typedef int i32x4 __attribute__((ext_vector_type(4)));
template <bool I8> struct AccSel { typedef f32x4 T; };
template <> struct AccSel<true> { typedef i32x4 T; };
template <bool I8> __device__ __forceinline__ typename AccSel<I8>::T mma1(bf16x8 b, bf16x8 a, typename AccSel<I8>::T c) {
    if constexpr (I8) return __builtin_amdgcn_mfma_i32_16x16x64_i8(__builtin_bit_cast(i32x4, b), __builtin_bit_cast(i32x4, a), c, 0, 0, 0);
    else return __builtin_amdgcn_mfma_f32_16x16x32_bf16(b, a, c, 0, 0, 0);
}
constexpr int BM = 256, BK = 64, HALF = 128, HTB = HALF * BK * 2  , STAGE_BYTES = 8 * HTB, NXCD = 8, WGM = 8;

__host__ __device__ __forceinline__ int lds_byte(int r, int c) { const int st = (r >> 4) * 2 + (c >> 5), rr = r & 15, cc = c & 31, ob = rr * 64 + cc * 2; return st * 1024 + (ob ^ (((ob >> 9) & 1) << 5)); }
__host__ __device__ __forceinline__ void stage_rc(int b, int& R, int& C) { const int st = b / 1024, sb = b % 1024, swz = sb ^ (((sb >> 9) & 1) << 5); R = (st >> 1) * 16 + swz / 64; C = (st & 1) * 32 + (swz % 64) / 2; }
__host__ __device__ __forceinline__ int perm32(int rho) { const int n = rho >> 4, i = rho & 15; return 8 * (i >> 2) + 4 * n + (i & 3); }

struct Unit { int pm, pn; long aoff, boff; int e; };
struct Gemm { const bf16_t* A; const bf16_t* Bt; int K, lda, ldb; };

struct Order {
    int nM, nN, nwg, G, c, mode, lyr, u0, uend; long a_pm, a_pn, b0, b_pn, b_pb, b_e; const int* estart;
    __device__ void init(int nM_, int nN_, int G_, int c_) { nM = nM_; nN = nN_; nwg = nM * nN; G = G_; c = c_; u0 = 0; uend = nwg; mode = 0; lyr = 0; a_pm = 0; a_pn = 0; b0 = 0; b_pn = 0; b_pb = 0; b_e = 0; estart = nullptr; }
    __device__ void plain(int lda, int ldb) { a_pm = 256L * lda * 2; b_pn = 256L * ldb * 2; }
    __device__ bool next(int i, Unit& u) const {
        const long L = (long)u0 + (long)i * G + c; if (L >= uend) return false;
        int wgid = (int)L; { const int q = nwg / NXCD, r = nwg % NXCD, xcd = wgid % NXCD, off = wgid / NXCD; wgid = (xcd < r ? xcd * (q + 1) : r * (q + 1) + (xcd - r) * q) + off; }
        const int nig = WGM * nN, gid = wgid / nig, fm = gid * WGM, gsz = (nM - fm) < WGM ? (nM - fm) : WGM;
        u.pm = fm + ((wgid % nig) % gsz); u.pn = (wgid % nig) / gsz;
        long e = 0; if (estart && mode == 0) { const int r0 = u.pm * 256;
#pragma unroll
            for (int j = 1; j < 8; ++j) e += (r0 >= __builtin_amdgcn_readfirstlane(estart[j])) ? 1 : 0; }
        if (mode == 1)      { const long l = lyr, b = (u.pm >> 2) & 15, hh = u.pm & 3; u.aoff = ((b * 256) * 4096 + l * 1024 + hh * 256) * 2; u.boff = ((l * 1024 + u.pn * 256) * 1024 + hh * 256) * 2; }
        else if (mode == 2) { const long l = lyr, b = (u.pm >> 2) & 15, nt = u.pm & 3; u.aoff = ((l * 1024 + nt * 256) * 1024 + u.pn * 256) * 2; u.boff = ((b * 256) * 4096 + l * 1024 + u.pn * 256) * 2; }
        else if (mode == 3) { const int pmo = u.pm / 11, ks = u.pm - pmo * 11; const int r0 = (256 + pmo) * 256; long e3 = 0;
#pragma unroll
            for (int j = 1; j < 8; ++j) e3 += (r0 >= __builtin_amdgcn_readfirstlane(estart[j])) ? 1 : 0;
            u.aoff = ((long)r0 * 2816 + ks * 256) * 2; u.boff = ((e3 * 1024 + u.pn * 256) * 2816 + ks * 256) * 2; }
        else { u.aoff = u.pm * a_pm + u.pn * a_pn; u.boff = b0 + u.pn * b_pn + (long)(u.pm >> 3) * b_pb + e * b_e; }
        u.e = (int)e; return true;
    }
    __device__ __forceinline__ void a_ready(const Unit&) const {}
    __device__ __forceinline__ void done(const Unit&) const {}
};

__device__ __forceinline__ unsigned cvt_pk_bf16(float lo, float hi) { unsigned r; asm volatile("v_cvt_pk_bf16_f32 %0, %1, %2" : "=v"(r) : "v"(lo), "v"(hi)); return r; }
__device__ __forceinline__ float bflo(unsigned w) { return __uint_as_float(w << 16); }
__device__ __forceinline__ float bfhi(unsigned w) { return __uint_as_float(w & 0xffff0000u); }
__device__ __forceinline__ float rstd16(const float* ssq, int r) {
    const f32x4* p = (const f32x4*)(ssq + (size_t)r * 16); const f32x4 a = p[0], b = p[1], c = p[2], d = p[3];
    const float s = (((a[0] + a[1]) + (a[2] + a[3])) + ((b[0] + b[1]) + (b[2] + b[3]))) + (((c[0] + c[1]) + (c[2] + c[3])) + ((d[0] + d[1]) + (d[2] + d[3])));
    return __builtin_amdgcn_rsqf(s * (1.0f / 1024.0f) + 1e-6f);
}

struct EpiF32 {
    static constexpr bool PERM = true, AFTER_DRAIN = false;
    float* C; int ldc;
    __device__ __forceinline__ void operator()(const f32x4 (&acc)[2][2][4][2], const Unit& u, int wr, int wc, int fr, int fq) const {
        const int row0 = u.pm * BM + wr * 64 + fr, col0 = u.pn * BM + wc * 32 + 8 * fq;
#pragma unroll
        for (int ai = 0; ai < 2; ++ai)
#pragma unroll
            for (int m = 0; m < 4; ++m) { float* rowp = C + (size_t)(row0 + ai * HALF + m * 16) * ldc + col0;
#pragma unroll
                for (int bj = 0; bj < 2; ++bj) { *(f32x4*)(rowp + bj * HALF) = acc[ai][bj][m][0]; *(f32x4*)(rowp + bj * HALF + 4) = acc[ai][bj][m][1]; } }
    }
};
struct EpiBf16 {
    static constexpr bool PERM = true, AFTER_DRAIN = false;
    bf16_t* O; int ldc;
    __device__ __forceinline__ void operator()(const f32x4 (&acc)[2][2][4][2], const Unit& u, int wr, int wc, int fr, int fq) const {
        const int row0 = u.pm * BM + wr * 64 + fr, col0 = u.pn * BM + wc * 32 + 8 * fq;
#pragma unroll
        for (int ai = 0; ai < 2; ++ai)
#pragma unroll
            for (int m = 0; m < 4; ++m) { bf16_t* rowp = O + (size_t)(row0 + ai * HALF + m * 16) * ldc + col0;
#pragma unroll
                for (int bj = 0; bj < 2; ++bj) { const f32x4 v0 = acc[ai][bj][m][0], v1 = acc[ai][bj][m][1];
                    u32x4 w; w.x = cvt_pk_bf16(v0[0], v0[1]); w.y = cvt_pk_bf16(v0[2], v0[3]); w.z = cvt_pk_bf16(v1[0], v1[1]); w.w = cvt_pk_bf16(v1[2], v1[3]);
                    *(u32x4*)(rowp + bj * HALF) = w; } }
    }
};
struct EpiScale {
    static constexpr bool PERM = true, AFTER_DRAIN = false;
    bf16_t* O; int ldc; const float* ssq;
    __device__ __forceinline__ void operator()(const f32x4 (&acc)[2][2][4][2], const Unit& u, int wr, int wc, int fr, int fq) const {
        const int row0 = u.pm * BM + wr * 64 + fr, col0 = u.pn * BM + wc * 32 + 8 * fq;
#pragma unroll
        for (int ai = 0; ai < 2; ++ai)
#pragma unroll
            for (int m = 0; m < 4; ++m) { const int r = row0 + ai * HALF + m * 16; const float rs = rstd16(ssq, r); bf16_t* rowp = O + (size_t)r * ldc + col0;
#pragma unroll
                for (int bj = 0; bj < 2; ++bj) { const f32x4 v0 = acc[ai][bj][m][0] * rs, v1 = acc[ai][bj][m][1] * rs;
                    u32x4 w; w.x = cvt_pk_bf16(v0[0], v0[1]); w.y = cvt_pk_bf16(v0[2], v0[3]); w.z = cvt_pk_bf16(v1[0], v1[1]); w.w = cvt_pk_bf16(v1[2], v1[3]);
                    *(u32x4*)(rowp + bj * HALF) = w; } }
    }
};
struct EpiRes {
    static constexpr bool PERM = true, AFTER_DRAIN = false;
    bf16_t* H; float* ssq;
    __device__ __forceinline__ void operator()(const f32x4 (&acc)[2][2][4][2], const Unit& u, int wr, int wc, int fr, int fq) const {
        const int row0 = u.pm * BM + wr * 64 + fr, col0 = u.pn * BM + wc * 32 + 8 * fq;
#pragma unroll
        for (int ai = 0; ai < 2; ++ai)
#pragma unroll
            for (int m = 0; m < 4; ++m) { const int r = row0 + ai * HALF + m * 16; bf16_t* rowp = H + (size_t)r * 1024 + col0; float s = 0.f;
#pragma unroll
                for (int bj = 0; bj < 2; ++bj) { const u32x4 o = *(const u32x4*)(rowp + bj * HALF); const f32x4 a0 = acc[ai][bj][m][0], a1 = acc[ai][bj][m][1];
                    u32x4 w; w.x = cvt_pk_bf16(a0[0] + bflo(o.x), a0[1] + bfhi(o.x)); w.y = cvt_pk_bf16(a0[2] + bflo(o.y), a0[3] + bfhi(o.y));
                    w.z = cvt_pk_bf16(a1[0] + bflo(o.z), a1[1] + bfhi(o.z)); w.w = cvt_pk_bf16(a1[2] + bflo(o.w), a1[3] + bfhi(o.w));
                    *(u32x4*)(rowp + bj * HALF) = w;
                    s += (bflo(w.x) * bflo(w.x) + bfhi(w.x) * bfhi(w.x)) + (bflo(w.y) * bflo(w.y) + bfhi(w.y) * bfhi(w.y)) + (bflo(w.z) * bflo(w.z) + bfhi(w.z) * bfhi(w.z)) + (bflo(w.w) * bflo(w.w) + bfhi(w.w) * bfhi(w.w)); }
                s += __shfl_xor(s, 16); s += __shfl_xor(s, 32);
                if (fq == 0) ssq[(size_t)r * 16 + u.pn * 4 + wc] = s; }
    }
};
struct EpiSoftmax {
    static constexpr bool PERM = true, AFTER_DRAIN = false;
    bf16_t* O; int ldc; PG8_LAS float* tab; const float* ssq;
    __device__ __forceinline__ void operator()(f32x4 (&acc)[2][2][4][2], const Unit& u, int wr, int wc, int fr, int fq) const {
        const int row0 = u.pm * BM + wr * 64 + fr, col0 = u.pn * BM + wc * 32 + 8 * fq;
#pragma unroll
        for (int ai = 0; ai < 2; ++ai)
#pragma unroll
            for (int m = 0; m < 4; ++m) { float mx = -3.0e38f; const float rs = ssq ? rstd16(ssq, row0 + ai * HALF + m * 16) : 1.0f;
#pragma unroll
                for (int bj = 0; bj < 2; ++bj)
#pragma unroll
                    for (int n = 0; n < 2; ++n) { const f32x4 x = acc[ai][bj][m][n] * rs; acc[ai][bj][m][n] = x; mx = fmaxf(mx, fmaxf(fmaxf(x[0], x[1]), fmaxf(x[2], x[3]))); }
                mx = fmaxf(mx, __shfl_xor(mx, 16)); mx = fmaxf(mx, __shfl_xor(mx, 32));
                if (fq == 0) tab[(ai * HALF + wr * 64 + m * 16 + fr) * 4 + wc] = mx; }
        asm volatile("s_waitcnt lgkmcnt(0)" ::: "memory"); __builtin_amdgcn_s_barrier(); asm volatile("" ::: "memory");
#pragma unroll
        for (int ai = 0; ai < 2; ++ai)
#pragma unroll
            for (int m = 0; m < 4; ++m) { const int rl = ai * HALF + wr * 64 + m * 16 + fr; const f32x4 t = *(const PG8_LAS f32x4*)(tab + rl * 4); const float M = fmaxf(fmaxf(t[0], t[1]), fmaxf(t[2], t[3])); float s = 0.f;
#pragma unroll
                for (int bj = 0; bj < 2; ++bj)
#pragma unroll
                    for (int n = 0; n < 2; ++n) { f32x4 e;
#pragma unroll
                        for (int j = 0; j < 4; ++j) e[j] = __builtin_amdgcn_exp2f(acc[ai][bj][m][n][j] - M);
                        acc[ai][bj][m][n] = e; s += (e[0] + e[1]) + (e[2] + e[3]); }
                s += __shfl_xor(s, 16); s += __shfl_xor(s, 32);
                if (fq == 0) tab[1024 + rl * 4 + wc] = s; }
        asm volatile("s_waitcnt lgkmcnt(0)" ::: "memory"); __builtin_amdgcn_s_barrier(); asm volatile("" ::: "memory");
#pragma unroll
        for (int ai = 0; ai < 2; ++ai)
#pragma unroll
            for (int m = 0; m < 4; ++m) { const int rl = ai * HALF + wr * 64 + m * 16 + fr; const f32x4 t = *(const PG8_LAS f32x4*)(tab + 1024 + rl * 4); const float inv = 1.0f / ((t[0] + t[1]) + (t[2] + t[3]));
                bf16_t* rowp = O + (size_t)(row0 + ai * HALF + m * 16) * ldc + col0;
#pragma unroll
                for (int bj = 0; bj < 2; ++bj) { const f32x4 v0 = acc[ai][bj][m][0] * inv, v1 = acc[ai][bj][m][1] * inv;
                    u32x4 w; w.x = cvt_pk_bf16(v0[0], v0[1]); w.y = cvt_pk_bf16(v0[2], v0[3]); w.z = cvt_pk_bf16(v1[0], v1[1]); w.w = cvt_pk_bf16(v1[2], v1[3]);
                    *(u32x4*)(rowp + bj * HALF) = w; } }
    }
};
struct EpiGlu {
    static constexpr bool PERM = true, AFTER_DRAIN = false;
    const bf16_t* G; bf16_t* O; int ldc; const float* gain; PG8_LAS float* tab;
    __device__ __forceinline__ void operator()(f32x4 (&acc)[2][2][4][2], const Unit& u, int wr, int wc, int fr, int fq) const {
        const int row0 = u.pm * BM + wr * 64 + fr, col0 = wc * 32 + 8 * fq;
#pragma unroll
        for (int ai = 0; ai < 2; ++ai)
#pragma unroll
            for (int m = 0; m < 4; ++m) { const int r = row0 + ai * HALF + m * 16; float s = 0.f;
#pragma unroll
                for (int bj = 0; bj < 2; ++bj) { const u32x4 gv = *(const u32x4*)(G + (size_t)r * 256 + col0 + bj * HALF);
                    const float gg[8] = {bflo(gv.x), bfhi(gv.x), bflo(gv.y), bfhi(gv.y), bflo(gv.z), bfhi(gv.z), bflo(gv.w), bfhi(gv.w)};
#pragma unroll
                    for (int n = 0; n < 2; ++n) { f32x4 a;
#pragma unroll
                        for (int j = 0; j < 4; ++j) { a[j] = gg[4 * n + j] * __builtin_amdgcn_rcpf(1.0f + __expf(-acc[ai][bj][m][n][j])); s += a[j] * a[j]; }
                        acc[ai][bj][m][n] = a; } }
                s += __shfl_xor(s, 16); s += __shfl_xor(s, 32);
                if (fq == 0) tab[(ai * HALF + wr * 64 + m * 16 + fr) * 4 + wc] = s; }
        asm volatile("s_waitcnt lgkmcnt(0)" ::: "memory"); __builtin_amdgcn_s_barrier(); asm volatile("" ::: "memory");
#pragma unroll
        for (int ai = 0; ai < 2; ++ai)
#pragma unroll
            for (int m = 0; m < 4; ++m) { const int rl = ai * HALF + wr * 64 + m * 16 + fr; const f32x4 t = *(const PG8_LAS f32x4*)(tab + rl * 4); const float rs = 1.0f / sqrtf(((t[0] + t[1]) + (t[2] + t[3])) * (1.0f / 256.0f) + 1e-6f);
                bf16_t* rowp = O + (size_t)(row0 + ai * HALF + m * 16) * ldc + col0;
#pragma unroll
                for (int bj = 0; bj < 2; ++bj) { const f32x4 g0 = *(const f32x4*)(gain + col0 + bj * HALF), g1 = *(const f32x4*)(gain + col0 + bj * HALF + 4);
                    const f32x4 v0 = acc[ai][bj][m][0] * rs * g0, v1 = acc[ai][bj][m][1] * rs * g1;
                    u32x4 w; w.x = cvt_pk_bf16(v0[0], v0[1]); w.y = cvt_pk_bf16(v0[2], v0[3]); w.z = cvt_pk_bf16(v1[0], v1[1]); w.w = cvt_pk_bf16(v1[2], v1[3]);
                    *(u32x4*)(rowp + bj * HALF) = w; } }
    }
};
struct EpiScaleI8 {
    static constexpr bool PERM = true, AFTER_DRAIN = false;
    bf16_t* O; int ldc; const float* rsd; const float* wsc;
    __device__ __forceinline__ void operator()(const i32x4 (&acc)[2][2][4][2], const Unit& u, int wr, int wc, int fr, int fq) const {
        const int row0 = u.pm * BM + wr * 64 + fr, col0 = u.pn * BM + wc * 32 + 8 * fq;
        f32x4 sc[2][2];
#pragma unroll
        for (int bj = 0; bj < 2; ++bj) { sc[bj][0] = *(const f32x4*)(wsc + col0 + bj * HALF); sc[bj][1] = *(const f32x4*)(wsc + col0 + bj * HALF + 4); }
#pragma unroll
        for (int ai = 0; ai < 2; ++ai)
#pragma unroll
            for (int m = 0; m < 4; ++m) { const int r = row0 + ai * HALF + m * 16; const float rs = rsd[r]; bf16_t* rowp = O + (size_t)r * ldc + col0;
#pragma unroll
                for (int bj = 0; bj < 2; ++bj) { f32x4 v0, v1;
#pragma unroll
                    for (int j = 0; j < 4; ++j) { v0[j] = (float)acc[ai][bj][m][0][j] * (rs * sc[bj][0][j]); v1[j] = (float)acc[ai][bj][m][1][j] * (rs * sc[bj][1][j]); }
                    u32x4 w; w.x = cvt_pk_bf16(v0[0], v0[1]); w.y = cvt_pk_bf16(v0[2], v0[3]); w.z = cvt_pk_bf16(v1[0], v1[1]); w.w = cvt_pk_bf16(v1[2], v1[3]);
                    *(u32x4*)(rowp + bj * HALF) = w; } }
    }
};
struct EpiSwigluI8 {
    static constexpr bool PERM = true, AFTER_DRAIN = false;
    bf16_t* O; int ldc; const float* rsd; const float* wsc; int wstride;
    __device__ __forceinline__ void operator()(const i32x4 (&acc)[2][2][4][2], const Unit& u, int wr, int wc, int fr, int fq) const {
        const int row0 = u.pm * BM + wr * 64 + fr, col0 = u.pn * HALF + wc * 32 + 8 * fq;
        const float* ws_ = wsc + (size_t)u.e * wstride + u.pn * BM + wc * 32 + 8 * fq;
        const f32x4 sg0 = *(const f32x4*)ws_, sg1 = *(const f32x4*)(ws_ + 4), su0 = *(const f32x4*)(ws_ + HALF), su1 = *(const f32x4*)(ws_ + HALF + 4);
#pragma unroll
        for (int ai = 0; ai < 2; ++ai)
#pragma unroll
            for (int m = 0; m < 4; ++m) { const int r = row0 + ai * HALF + m * 16; const float rs = rsd[r];
                float o[8];
#pragma unroll
                for (int n = 0; n < 2; ++n)
#pragma unroll
                    for (int j = 0; j < 4; ++j) { const float g = (float)acc[ai][0][m][n][j] * (rs * (n ? sg1[j] : sg0[j])), up = (float)acc[ai][1][m][n][j] * (rs * (n ? su1[j] : su0[j])); o[4 * n + j] = g * up * __builtin_amdgcn_rcpf(1.0f + __expf(-g)); }
                u32x4 w; w.x = cvt_pk_bf16(o[0], o[1]); w.y = cvt_pk_bf16(o[2], o[3]); w.z = cvt_pk_bf16(o[4], o[5]); w.w = cvt_pk_bf16(o[6], o[7]);
                *(u32x4*)(O + (size_t)r * ldc + col0) = w; }
    }
};
struct EpiSwiglu {
    static constexpr bool PERM = true, AFTER_DRAIN = false;
    bf16_t* O; int ldc; const float* ssq; const float* rsd;
    __device__ __forceinline__ void operator()(const f32x4 (&acc)[2][2][4][2], const Unit& u, int wr, int wc, int fr, int fq) const {
        const int row0 = u.pm * BM + wr * 64 + fr, col0 = u.pn * HALF + wc * 32 + 8 * fq;
#pragma unroll
        for (int ai = 0; ai < 2; ++ai)
#pragma unroll
            for (int m = 0; m < 4; ++m) { const int r = row0 + ai * HALF + m * 16; const float rs = rsd ? rsd[r] : rstd16(ssq, r);
                float o[8];
#pragma unroll
                for (int n = 0; n < 2; ++n)
#pragma unroll
                    for (int j = 0; j < 4; ++j) { const float g = acc[ai][0][m][n][j] * rs, up = acc[ai][1][m][n][j] * rs; o[4 * n + j] = g * up * __builtin_amdgcn_rcpf(1.0f + __expf(-g)); }
                u32x4 w; w.x = cvt_pk_bf16(o[0], o[1]); w.y = cvt_pk_bf16(o[2], o[3]); w.z = cvt_pk_bf16(o[4], o[5]); w.w = cvt_pk_bf16(o[6], o[7]);
                *(u32x4*)(O + (size_t)r * ldc + col0) = w; }
    }
};
template <class Epi, class Sched, bool ALIGN_EPI = false, bool SP2 = false, bool I8 = false>
__device__ __forceinline__ void gemm_phase(PG8_LAS unsigned char* lds, const Gemm g, const Sched& S, const Epi& E, int wave_in) {
    int wid_ = wave_in; unsigned ones_ = ~0u; asm volatile("" : "+s"(wid_), "+s"(ones_));
    const int wid = wid_, lane = (int)__builtin_amdgcn_mbcnt_hi(ones_, __builtin_amdgcn_mbcnt_lo(ones_, 0u)), tid = wid * 64 + lane, wr = wid >> 2, wc = wid & 3, fr = lane & 15, fq = lane >> 4;
    int K_ = g.K; asm volatile("" : "+s"(K_)); const int K = K_, nt = K / BK;
    unsigned voffA[2], voffB[2];
#pragma unroll
    for (int i = 0; i < 2; ++i) { int R, C; stage_rc(tid * 16 + i * 8192, R, C); const int Rb = Epi::PERM ? ((R & ~31) + perm32(R & 31)) : R;
        voffA[i] = (unsigned)(R * g.lda + C) * 2u; voffB[i] = (unsigned)(Rb * g.ldb + C) * 2u; }
    const size_t kstep = (size_t)(BK * 2);
    const size_t hstepA = (size_t)HALF * g.lda * 2, hstepB = (size_t)HALF * g.ldb * 2;
    const unsigned ldsw = (unsigned)wid * 1024u;
    const int aoff = lds_byte(wr * 64 + fr, fq * 8), boff = lds_byte(wc * 32 + fr, fq * 8);
#define PG8_SA(b, h) (((b) * 2 + (h)) * HTB)
#define PG8_SB(b, h) ((4 + (b) * 2 + (h)) * HTB)
#define PG8_STAGE(bufoff, gbase, voff) do { _Pragma("unroll") for (int _i = 0; _i < 2; ++_i) \
        __builtin_amdgcn_global_load_lds((const unsigned*)((const char*)(gbase) + (voff)[_i]), (PG8_LAS unsigned*)(lds + (bufoff) + ldsw + _i * 8192), 16, 0, 0); } while (0)
#define PG8_LDA(dst, b, h) do { _Pragma("unroll") for (int m = 0; m < 4; ++m) _Pragma("unroll") for (int k = 0; k < 2; ++k) dst[m][k] = *(const PG8_LAS bf16x8*)(lds + PG8_SA(b, h) + aoff + m * 2048 + k * 1024); } while (0)
#define PG8_LDA_H(dst, b, h, m0) do { _Pragma("unroll") for (int m = (m0); m < (m0) + 2; ++m) _Pragma("unroll") for (int k = 0; k < 2; ++k) dst[m][k] = *(const PG8_LAS bf16x8*)(lds + PG8_SA(b, h) + aoff + m * 2048 + k * 1024); } while (0)
#define PG8_LDB(dst, b, h) do { _Pragma("unroll") for (int n = 0; n < 2; ++n) _Pragma("unroll") for (int k = 0; k < 2; ++k) dst[n][k] = *(const PG8_LAS bf16x8*)(lds + PG8_SB(b, h) + boff + n * 2048 + k * 1024); } while (0)
#define PG8_MMA(ai, bj, At, Bt) do { __builtin_amdgcn_s_setprio(1); _Pragma("unroll") for (int m = 0; m < 4; ++m) _Pragma("unroll") for (int n = 0; n < 2; ++n) _Pragma("unroll") for (int k = 0; k < 2; ++k) \
        acc[ai][bj][m][n] = mma1<I8>(Bt[n][k], At[m][k], acc[ai][bj][m][n]); __builtin_amdgcn_s_setprio(0); } while (0)
#define PG8_WAIT_V(n) asm volatile("s_waitcnt vmcnt(" #n ")" ::: "memory")
#define PG8_WAIT_L(n) asm volatile("s_waitcnt lgkmcnt(" #n ")" ::: "memory")
#define PG8_BAR __builtin_amdgcn_s_barrier()
#define PG8_SCHED __builtin_amdgcn_sched_barrier(0)
    Unit cur, nxt; int ui = 0;
    if (!S.next(0, cur)) return;
    typedef typename AccSel<I8>::T AccV; AccV acc[2][2][4][2];
#pragma unroll
    for (int a = 0; a < 2; ++a)
#pragma unroll
        for (int b = 0; b < 2; ++b)
#pragma unroll
            for (int m = 0; m < 4; ++m)
#pragma unroll
                for (int n = 0; n < 2; ++n) { AccV z_{}; acc[a][b][m][n] = z_; }
    bf16x8 At[4][2], B0[2][2], B1[2][2];
    const char* cA = (const char*)g.A + cur.aoff; const char* cB = (const char*)g.Bt + cur.boff;
    S.a_ready(cur);
    if constexpr (SP2) {
        PG8_STAGE(PG8_SB(0, 0), cB, voffB); PG8_STAGE(PG8_SB(0, 1), cB + hstepB, voffB); PG8_STAGE(PG8_SA(0, 0), cA, voffA); PG8_STAGE(PG8_SA(0, 1), cA + hstepA, voffA);
        if (wr == 1) PG8_BAR;
        PG8_WAIT_V(2); PG8_BAR;
        PG8_STAGE(PG8_SB(1, 0), cB + kstep, voffB); PG8_STAGE(PG8_SA(1, 0), cA + kstep, voffA); PG8_STAGE(PG8_SB(1, 1), cB + hstepB + kstep, voffB);
        PG8_WAIT_V(6); PG8_BAR;
    } else {
        PG8_STAGE(PG8_SB(0, 0), cB, voffB); PG8_STAGE(PG8_SA(0, 0), cA, voffA); PG8_STAGE(PG8_SB(0, 1), cB + hstepB, voffB); PG8_STAGE(PG8_SA(0, 1), cA + hstepA, voffA);
        if (wr == 1) PG8_BAR;
        PG8_WAIT_V(4); PG8_BAR;
        PG8_STAGE(PG8_SB(1, 0), cB + kstep, voffB); PG8_STAGE(PG8_SA(1, 0), cA + kstep, voffA); PG8_STAGE(PG8_SB(1, 1), cB + hstepB + kstep, voffB);
        PG8_WAIT_V(6); PG8_BAR;
    }
    for (;;) {
        const bool has_next = S.next(ui + 1, nxt);
        const char* nA = has_next ? (const char*)g.A + nxt.aoff : cA; const char* nB = has_next ? (const char*)g.Bt + nxt.boff : cB;
        for (int t = 0; t < nt; t += 2) {
            const bool last = (t == nt - 2);
            const char* a1 = cA + (size_t)(t + 1) * kstep;
            const char* a2 = last ? nA : cA + (size_t)(t + 2) * kstep; const char* b2 = last ? nB : cB + (size_t)(t + 2) * kstep;
            const char* a3 = a2 + kstep; const char* b3 = b2 + kstep;
            if (last && has_next) S.a_ready(nxt);
            if constexpr (SP2) {
            PG8_LDB(B0, 0, 0); PG8_LDB(B1, 0, 1); PG8_SCHED; PG8_LDA_H(At, 0, 0, 0); PG8_WAIT_L(8); PG8_LDA_H(At, 0, 0, 2); PG8_STAGE(PG8_SA(1, 1), a1 + hstepA, voffA);
            PG8_WAIT_V(8); PG8_WAIT_L(0); PG8_BAR; PG8_MMA(0, 0, At, B0); PG8_MMA(0, 1, At, B1); PG8_BAR; PG8_SCHED;
            PG8_LDA(At, 0, 1); PG8_STAGE(PG8_SB(0, 0), b2, voffB); PG8_STAGE(PG8_SB(0, 1), b2 + hstepB, voffB); PG8_STAGE(PG8_SA(0, 0), a2, voffA);
            PG8_WAIT_V(8); PG8_WAIT_L(0); PG8_BAR; PG8_MMA(1, 0, At, B0); PG8_MMA(1, 1, At, B1); PG8_BAR; PG8_SCHED;
            PG8_LDB(B0, 1, 0); PG8_LDB(B1, 1, 1); PG8_SCHED; PG8_LDA_H(At, 1, 0, 0); PG8_WAIT_L(8); PG8_LDA_H(At, 1, 0, 2); PG8_STAGE(PG8_SA(0, 1), a2 + hstepA, voffA);
            PG8_WAIT_V(8); PG8_WAIT_L(0); PG8_BAR; PG8_MMA(0, 0, At, B0); PG8_MMA(0, 1, At, B1); PG8_BAR; PG8_SCHED;
            PG8_LDA(At, 1, 1); PG8_STAGE(PG8_SB(1, 0), b3, voffB); PG8_STAGE(PG8_SB(1, 1), b3 + hstepB, voffB); PG8_STAGE(PG8_SA(1, 0), a3, voffA);
            PG8_WAIT_V(8); PG8_WAIT_L(0); PG8_BAR; PG8_MMA(1, 0, At, B0); PG8_MMA(1, 1, At, B1); PG8_BAR; PG8_SCHED;
            } else {
            PG8_LDB(B0, 0, 0); PG8_SCHED; PG8_LDA(At, 0, 0); PG8_STAGE(PG8_SA(1, 1), a1 + hstepA, voffA);
            PG8_WAIT_L(8); PG8_BAR; PG8_WAIT_L(0); PG8_MMA(0, 0, At, B0); PG8_BAR; PG8_SCHED;
            PG8_LDB(B1, 0, 1); PG8_STAGE(PG8_SB(0, 0), b2, voffB);
            PG8_BAR; PG8_WAIT_L(0); PG8_MMA(0, 1, At, B1); PG8_BAR;
            PG8_LDA(At, 0, 1); PG8_STAGE(PG8_SA(0, 0), a2, voffA);
            PG8_BAR; PG8_WAIT_L(0); PG8_MMA(1, 0, At, B0); PG8_BAR; PG8_SCHED;
            PG8_STAGE(PG8_SB(0, 1), b2 + hstepB, voffB);
            PG8_WAIT_V(6); PG8_BAR; PG8_MMA(1, 1, At, B1); PG8_BAR;
            PG8_LDB(B0, 1, 0); PG8_SCHED; PG8_LDA(At, 1, 0); PG8_STAGE(PG8_SA(0, 1), a2 + hstepA, voffA);
            PG8_WAIT_L(8); PG8_BAR; PG8_WAIT_L(0); PG8_MMA(0, 0, At, B0); PG8_BAR; PG8_SCHED;
            PG8_LDB(B1, 1, 1); PG8_STAGE(PG8_SB(1, 0), b3, voffB);
            PG8_BAR; PG8_WAIT_L(0); PG8_MMA(0, 1, At, B1); PG8_BAR;
            PG8_LDA(At, 1, 1); PG8_STAGE(PG8_SA(1, 0), a3, voffA);
            PG8_BAR; PG8_WAIT_L(0); PG8_MMA(1, 0, At, B0); PG8_BAR; PG8_SCHED;
            PG8_STAGE(PG8_SB(1, 1), b3 + hstepB, voffB);
            PG8_WAIT_V(6); PG8_BAR; PG8_MMA(1, 1, At, B1); PG8_BAR;
            }
        }
        if constexpr (ALIGN_EPI) { if (wr == 0) PG8_BAR; }
        if constexpr (!Epi::AFTER_DRAIN) { E(acc, cur, wr, wc, fr, fq); S.done(cur); }
        if (!has_next) break;
#pragma unroll
        for (int a = 0; a < 2; ++a)
#pragma unroll
            for (int b = 0; b < 2; ++b)
#pragma unroll
                for (int m = 0; m < 4; ++m)
#pragma unroll
                    for (int n = 0; n < 2; ++n) { AccV z_{}; acc[a][b][m][n] = z_; }
        cur = nxt; cA = nA; cB = nB; ++ui;
        if constexpr (ALIGN_EPI) { if (wr == 1) PG8_BAR; }
    }
    PG8_WAIT_V(0);
    if constexpr (!ALIGN_EPI) { if (wr == 0) PG8_BAR; }
    PG8_BAR;
    if constexpr (Epi::AFTER_DRAIN) { E.fused(acc, cur, wr, wc, fr, fq, lds, wid, lane); S.done(cur); }
#undef PG8_SA
#undef PG8_SB
#undef PG8_STAGE
#undef PG8_LDA
#undef PG8_LDB
#undef PG8_MMA
#undef PG8_WAIT_V
#undef PG8_WAIT_L
#undef PG8_BAR
#undef PG8_SCHED
}
}

#define XB_TMO      128
#define XB_XCNT(j)  (256  + 64 * (j))
#define XB_XSUB(j)  (1280 + 64 * (j))
#define XB_XGEN(j)  (2304 + 64 * (j))
#define XB_TOP      3328
#define XB_TOPGEN   3392
#define XCD_BAR_WORDS 3456
#define XB_SPIN_CAP (1u << 22)
#define LAS __attribute__((address_space(3)))

__device__ __forceinline__ unsigned xb_ld(unsigned* p)              { return __hip_atomic_load(p, __ATOMIC_RELAXED, __HIP_MEMORY_SCOPE_AGENT); }
__device__ __forceinline__ unsigned xb_add(unsigned* p, unsigned v) { return __hip_atomic_fetch_add(p, v, __ATOMIC_RELAXED, __HIP_MEMORY_SCOPE_AGENT); }
__device__ __forceinline__ unsigned xb_xcc_id() { return (unsigned)__builtin_amdgcn_s_getreg((3 << 11) | 20) & 0xFu; }
#define XB_SPIN(cond, bar) do { unsigned _sp = 0; while (cond) { __builtin_amdgcn_s_sleep(1); \
    if ((++_sp & 255u) == 0u) { if (xb_ld(&(bar)[XB_TMO])) break; if (_sp > XB_SPIN_CAP) { atomicAdd(&(bar)[XB_TMO], 1u); break; } } } } while (0)

struct XcdBarrier {
    unsigned* bar; unsigned x;
    volatile LAS unsigned* st;
};

__device__ __forceinline__ XcdBarrier xcd_barrier_post(unsigned* bar, volatile LAS unsigned* st) {
    XcdBarrier b; b.bar = bar; b.x = xb_xcc_id(); b.st = st;
    if (threadIdx.x == 0) (void)xb_add(&bar[XB_XCNT(b.x)], 1u);
    return b;
}
__device__ __forceinline__ void xcd_barrier_complete(unsigned* bar, unsigned x, unsigned& nloc, unsigned& nx) {
    const unsigned G = gridDim.x * gridDim.y * gridDim.z;
    unsigned sum, cnt, mine, sp = 0u;
    for (;;) {
        sum = 0u; cnt = 0u; mine = 0u;
#pragma unroll
        for (unsigned j = 0; j < 16; ++j) { const unsigned c = xb_ld(&bar[XB_XCNT(j)]); sum += c; cnt += (c > 0u) ? 1u : 0u; mine = (j == x) ? c : mine; }
        if (sum == G) break;
        __builtin_amdgcn_s_sleep(1);
        if ((++sp & 255u) == 0u) { if (xb_ld(&bar[XB_TMO])) break; if (sp > XB_SPIN_CAP) { atomicAdd(&bar[XB_TMO], 1u); break; } }
    }
    nloc = mine > 0u ? mine : 1u; nx = cnt > 0u ? cnt : 1u;
}

__device__ __forceinline__ void xcd_barrier(const XcdBarrier& b) {
    asm volatile("s_waitcnt vmcnt(0)" ::: "memory");
    __syncthreads();
    if (threadIdx.x == 0) {
        unsigned* bar = b.bar;
        __builtin_amdgcn_s_waitcnt(0);
        unsigned nloc = b.st[0], nx = b.st[1];
        if (nloc == 0u) { xcd_barrier_complete(bar, b.x, nloc, nx); b.st[0] = nloc; b.st[1] = nx; }
        const unsigned old = xb_add(&bar[XB_XSUB(b.x)], 1u);
        const unsigned gen = old / nloc;
        if (old + 1u == (gen + 1u) * nloc) {
            __builtin_amdgcn_fence(__ATOMIC_RELEASE, "agent");
            asm volatile("s_waitcnt vmcnt(0)" ::: "memory");
            const unsigned og = xb_add(&bar[XB_TOP], 1u);
            const unsigned tg = og / nx;
            if (og + 1u == (tg + 1u) * nx) xb_add(&bar[XB_TOPGEN], 1u);
            else XB_SPIN(xb_ld(&bar[XB_TOPGEN]) == tg, bar);
            __builtin_amdgcn_fence(__ATOMIC_ACQUIRE, "agent");
            xb_add(&bar[XB_XGEN(b.x)], 1u);
            asm volatile("s_waitcnt vmcnt(0)" ::: "memory");
        } else {
            XB_SPIN(xb_ld(&bar[XB_XGEN(b.x)]) == gen, bar);
            __builtin_amdgcn_fence(__ATOMIC_ACQUIRE, "agent");
            asm volatile("s_waitcnt vmcnt(0)" ::: "memory");
        }
    }
    __syncthreads();
}

constexpr int NB = 16, SEQ = 2048, DM = 1024, NL = 4, MEMLEN = 256, INC = 2816, FF = 2816, NEXP = 8;
constexpr int T = NB * SEQ;
constexpr int MROWS = NB * MEMLEN;
constexpr int MOE_ROWS = 2 * T + NEXP * 256;
constexpr int O_RET = 256, O_SB = 1280;
constexpr float NORM_EPS = 1e-6f;

constexpr size_t MiB = 1u << 20;
constexpr size_t WS_CTL = 0;
constexpr size_t WS_SSQ = 1 * MiB;
constexpr size_t WS_ROPE = 3 * MiB;
constexpr size_t WS_WR = 3 * MiB + 512 * 1024;
constexpr size_t WS_MOEI = 4 * MiB;
constexpr size_t WS_MEMN = 8 * MiB;
constexpr size_t WS_KC = 16 * MiB;
constexpr size_t WS_VT = 48 * MiB;
constexpr size_t WS_H = 80 * MiB;
constexpr size_t WS_WIN = 144 * MiB, WS_WGLU = 166 * MiB, WS_WOUT = 167 * MiB, WS_WCQ = 175 * MiB, WS_WCK = 183 * MiB, WS_WCV = 191 * MiB, WS_WCO = 199 * MiB;
constexpr size_t WS_WDGU = 207 * MiB, WS_WDDN = 229 * MiB, WS_WEGU = 240 * MiB, WS_WEDN = 416 * MiB;
constexpr size_t WS_AR = 504 * MiB;
constexpr size_t AR_PROJ = WS_AR, AR_Y = WS_AR + 176 * MiB, AR_G = WS_AR + 240 * MiB, AR_Z = WS_AR + 256 * MiB, AR_XS = WS_AR + 272 * MiB;
constexpr size_t AR_QC = WS_AR, AR_SC = WS_AR + 64 * MiB, AR_PB = WS_AR + 192 * MiB, AR_OC = WS_AR + 256 * MiB;
constexpr size_t AR_ACT = WS_AR;
constexpr size_t AR_XG = WS_AR, AR_ACTG = WS_AR + 132 * MiB, AR_DG = WS_AR + 495 * MiB;
constexpr size_t WS_WK = WS_AR + 627 * MiB;
constexpr size_t WS_VO = WS_WK + 32 * MiB;
constexpr size_t WS_Q8W = WS_VO + 32 * MiB;
constexpr size_t WS_Q8S = WS_Q8W + 100 * MiB;
constexpr size_t WS_Q8IN = WS_Q8S + 1 * MiB;
constexpr size_t WS_Q8INS = WS_Q8IN + 11 * MiB;
constexpr size_t WS_END = WS_Q8INS + 1 * MiB;
static_assert((size_t)18 * 2 * FF * DM <= 100 * MiB, "int8 weight region");
static_assert((size_t)T * INC * 2 <= 176 * MiB && (size_t)T * 16 * 128 * 4 <= 256 * MiB && (size_t)MOE_ROWS * 1024 * 2 <= 132 * MiB && (size_t)MOE_ROWS * FF * 2 <= 363 * MiB, "arena map");
constexpr size_t MI_CNT = 0, MI_EST = 16384, MI_TOPI = 32768, MI_TOPG = MI_TOPI + (size_t)T * 8, MI_RSTD = MI_TOPG + (size_t)T * 8, MI_POS = MI_RSTD + (size_t)T * 4, MI_RSTDG = MI_POS + (size_t)T * 8, MI_RSC0 = 2 * MiB;
static_assert(MI_RSTDG + (size_t)MOE_ROWS * 4 <= 2 * MiB && MI_RSC0 + (size_t)T * 4 <= 4 * MiB, "moe tables");

constexpr int RING_BYTES = 131072;
constexpr int MISC_OFF = RING_BYTES + 320;
constexpr int TAB_OFF = MISC_OFF + 128;
constexpr int LDS_BYTES = 147456;

#define GAS __attribute__((address_space(1)))
typedef unsigned short bf16;
typedef unsigned v4u __attribute__((ext_vector_type(4)));
typedef unsigned v2u __attribute__((ext_vector_type(2)));
typedef float f32x4 __attribute__((ext_vector_type(4)));
__device__ __forceinline__ float bf2f(unsigned v) { return __uint_as_float(v << 16); }
__device__ __forceinline__ float bflo(unsigned w) { return __uint_as_float(w << 16); }
__device__ __forceinline__ float bfhi(unsigned w) { return __uint_as_float(w & 0xffff0000u); }
__device__ __forceinline__ unsigned f2bf(float f) { unsigned u = __float_as_uint(f); return (u + 0x7fffu + ((u >> 16) & 1u)) >> 16; }
__device__ __forceinline__ unsigned pk2(float lo, float hi) { return f2bf(lo) | (f2bf(hi) << 16); }
__device__ __forceinline__ float wave_sum(float v) {
#pragma unroll
    for (int o = 1; o < 64; o <<= 1) v += __shfl_xor(v, o);
    return v;
}
__device__ __forceinline__ float wave_max(float v) {
#pragma unroll
    for (int o = 1; o < 64; o <<= 1) v = fmaxf(v, __shfl_xor(v, o));
    return v;
}
__device__ __forceinline__ void unpack8(const v4u w, float* f) { f[0] = bflo(w.x); f[1] = bfhi(w.x); f[2] = bflo(w.y); f[3] = bfhi(w.y); f[4] = bflo(w.z); f[5] = bfhi(w.z); f[6] = bflo(w.w); f[7] = bfhi(w.w); }
__device__ __forceinline__ void load64(const bf16* p, float* f) {
#pragma unroll
    for (int i = 0; i < 8; ++i) unpack8(((const v4u*)p)[i], f + 8 * i);
}
__device__ __forceinline__ float rstd16(const float* ssq, int r) { return pg8::rstd16(ssq, r); }

struct P { const float* in[27]; float* out; unsigned char* ws; int ph_lo, ph_hi; };
typedef const __attribute__((address_space(4))) P* KP;

__device__ __forceinline__ v2u q8_pack8(const float* v, float inv) { unsigned b[8];
#pragma unroll
    for (int j = 0; j < 8; ++j) b[j] = (unsigned)(int)__builtin_rintf(v[j] * inv) & 0xffu;
    v2u o; o.x = b[0] | (b[1] << 8) | (b[2] << 16) | (b[3] << 24); o.y = b[4] | (b[5] << 8) | (b[6] << 16) | (b[7] << 24); return o; }
__device__ __forceinline__ float absmax16(const float* a, const float* b) { float m = 0.f;
#pragma unroll
    for (int j = 0; j < 8; ++j) m = fmaxf(m, fmaxf(fabsf(a[j]), fabsf(b[j])));
    return wave_max(m); }

struct TrD { const float* W; bf16* WT; const float* wn; float sc; int ldw, K, mode, k0, n0; };
__device__ __forceinline__ TrD tr_desc(KP p, GAS unsigned char* ws, int it) {
    constexpr int I_GLU = 4 * 1, I_SQ = 16 * 4, I_DN = 44 * 4;
    constexpr int E0 = 0, E1 = E0 + 4 * I_GLU, E2 = E1 + 4 * I_SQ, E3 = E2, E4 = E3 + 4 * I_SQ, E5 = E4 + 4 * I_SQ, E6 = E5 + 4 * I_SQ, E8 = E6 + 2 * I_DN;
    TrD d; d.wn = nullptr; d.sc = 1.f; d.mode = 0; int item, N;
    if (it < E1) { const int r = it - E0, l = r / I_GLU; item = r % I_GLU; d.W = ((const float*)(GAS const float*)p->in[12]) + (size_t)l * 256 * 256; d.ldw = 256; d.K = 256; N = 256; d.WT = (bf16*)(ws + WS_WGLU) + (size_t)l * 256 * 256; }
    else if (it < E2) { const int r = it - E1, l = r / I_SQ; item = r % I_SQ; d.W = ((const float*)(GAS const float*)p->in[14]) + (size_t)l * DM * DM; d.ldw = DM; d.K = DM; N = DM; d.WT = (bf16*)(ws + WS_WOUT) + (size_t)l * DM * DM; }
    else if (it < E4) { const int r = it - E3, l = r / I_SQ; item = r % I_SQ; d.W = ((const float*)(GAS const float*)p->in[18]) + (size_t)l * DM * 2 * DM; d.ldw = 2 * DM; d.K = DM; N = DM; d.WT = (bf16*)(ws + WS_WCK) + (size_t)l * DM * DM; }
    else if (it < E5) { const int r = it - E4, l = r / I_SQ; item = r % I_SQ; d.W = ((const float*)(GAS const float*)p->in[18]) + (size_t)l * DM * 2 * DM + DM; d.ldw = 2 * DM; d.K = DM; N = DM; d.WT = (bf16*)(ws + WS_WCV) + (size_t)l * DM * DM; }
    else if (it < E6) { const int r = it - E5, l = r / I_SQ; item = r % I_SQ; d.W = ((const float*)(GAS const float*)p->in[19]) + (size_t)l * DM * DM; d.ldw = DM; d.K = DM; N = DM; d.WT = (bf16*)(ws + WS_WCO) + (size_t)l * DM * DM; }
    else if (it < E8) { const int r = it - E6, i = r / I_DN; item = r % I_DN; d.W = ((const float*)(GAS const float*)p->in[22]) + (size_t)i * FF * DM; d.ldw = DM; d.K = FF; N = DM; d.WT = (bf16*)(ws + WS_WDDN) + (size_t)i * DM * FF; }
    else              { const int r = it - E8, ie = r / I_DN; item = r % I_DN; d.W = ((const float*)(GAS const float*)p->in[25]) + (size_t)ie * FF * DM; d.ldw = DM; d.K = FF; N = DM; d.WT = (bf16*)(ws + WS_WEDN) + (size_t)ie * DM * FF; }
    const int nblk = N / 256; d.k0 = 64 * (item / nblk); d.n0 = 256 * (item % nblk);
    return d;
}
constexpr int TR_TOTAL = 4 * 4 + 4 * 4 * 64 + 2 * 176 + 16 * 176;
__device__ __forceinline__ void tr_load(const TrD& d, f32x4 (&v)[8], int tid) {
    const float* src = d.W + (size_t)(d.k0 + (tid >> 6)) * d.ldw + d.n0 + 4 * (tid & 63);
#pragma unroll
    for (int i = 0; i < 8; ++i) v[i] = *(const f32x4*)(src + (size_t)(8 * i) * d.ldw);
}
struct SqD { const float* W; const float* wn; unsigned char* Q; float* QS; int ldw, n0, dr0; };
constexpr int SQ_GU = 18 * 176, SQ_TOTAL = SQ_GU + 4 * 88;
__device__ __forceinline__ SqD sq_desc(KP p, GAS unsigned char* ws, int s) {
    SqD d;
    if (s < SQ_GU) { const int m = s / 176, j = s % 176; const int n = 32 * j, jj = n >= FF ? n - FF : n; d.n0 = n; d.ldw = 2 * FF; d.dr0 = (jj / 128) * 256 + (jj % 128) + (n >= FF ? 128 : 0);
        if (m < 2) { d.W = ((const float*)(GAS const float*)p->in[21]) + (size_t)m * DM * 2 * FF; d.wn = ((const float*)(GAS const float*)p->in[20]) + (2 * m) * DM; }
        else { const int ie = m - 2; d.W = ((const float*)(GAS const float*)p->in[24]) + (size_t)ie * DM * 2 * FF; d.wn = ((const float*)(GAS const float*)p->in[20]) + (2 * (ie / NEXP) + 1) * DM; }
        d.Q = (unsigned char*)(ws + WS_Q8W) + (size_t)m * 2 * FF * DM; d.QS = (float*)(ws + WS_Q8S) + (size_t)m * 2 * FF; }
    else { const int r = s - SQ_GU, l = r / 88, j = r % 88; d.n0 = 32 * j; d.dr0 = 32 * j; d.ldw = INC; d.W = ((const float*)(GAS const float*)p->in[3]) + (size_t)l * DM * INC; d.wn = ((const float*)(GAS const float*)p->in[2]) + l * DM;
        d.Q = (unsigned char*)(ws + WS_Q8IN) + (size_t)l * INC * DM; d.QS = (float*)(ws + WS_Q8INS) + (size_t)l * INC; }
    return d;
}
__device__ __forceinline__ void sq_load(const SqD& d, f32x4 (&v)[16], int tid) {
    const float* src = d.W + (size_t)(tid >> 3) * d.ldw + d.n0 + 4 * (tid & 7);
#pragma unroll
    for (int i = 0; i < 16; ++i) v[i] = *(const f32x4*)(src + (size_t)(64 * i) * d.ldw);
}
constexpr int SQ_PRO = 2 * 176 + 4 * 88, TR_PRO = TR_TOTAL - 16 * 176;
#define SQ_MAP(j) ((j) < 2 * 176 ? (j) : (j) + 16 * 176)
constexpr int CONV_PER = 8 * 176 * 2;
__device__ __forceinline__ void conv_unit(KP p, GAS unsigned char* ws, LAS unsigned char* lds, int half, int c, int wave, int lane, int tid) {
    if (c < 8 * 176) {
        const SqD cur = sq_desc(p, ws, 2 * 176 + half * 8 * 176 + c); f32x4 v[16]; sq_load(cur, v, tid);
        { const int kr = tid >> 3, ch = tid & 7;
#pragma unroll
          for (int i = 0; i < 16; ++i) { const int k = 64 * i + kr; const float s = cur.wn[k]; LAS unsigned short* d = (LAS unsigned short*)(lds + (4 * ch) * 2048 + (((k >> 3) ^ ch) << 4) + 2 * (k & 7));
#pragma unroll
              for (int e = 0; e < 4; ++e) d[e * 1024] = (unsigned short)f2bf(v[i][e] * s);
              if ((i & 1) == 1) asm volatile("s_waitcnt lgkmcnt(0)" ::: "memory"); } }
        __syncthreads();
#pragma unroll
        for (int j = 0; j < 4; ++j) { const int row = 4 * wave + j; const LAS unsigned char* src = lds + row * 2048; float a[8], b2[8];
            unpack8(*(const LAS v4u*)(src + ((lane ^ wave) << 4)), a); unpack8(*(const LAS v4u*)(src + (((64 + lane) ^ wave) << 4)), b2);
            const float mx = absmax16(a, b2), step = mx > 0.f ? mx * (1.0f / 127.0f) : 1.0f, inv = 1.0f / step;
            unsigned char* qd = cur.Q + (size_t)(cur.dr0 + row) * DM;
            ((v2u*)qd)[lane] = q8_pack8(a, inv); ((v2u*)(qd + 512))[lane] = q8_pack8(b2, inv);
            if (lane == 0) cur.QS[cur.dr0 + row] = step; }
        __syncthreads();
    } else {
        LAS float* T0 = (LAS float*)lds; const TrD cur = tr_desc(p, ws, TR_PRO + half * 8 * 176 + (c - 8 * 176)); f32x4 v[8]; tr_load(cur, v, tid);
        { const int r = tid >> 6, ch = tid & 63;
#pragma unroll
          for (int i = 0; i < 8; ++i) { const int k = 8 * i + r; const float s = cur.wn ? cur.wn[cur.k0 + k] * cur.sc : cur.sc; *(LAS f32x4*)(T0 + k * 256 + ((ch ^ (i & 7)) << 2)) = v[i] * s; } }
        __syncthreads();
        { const int c8 = tid & 7;
#pragma unroll
          for (int j = 0; j < 4; ++j) { const int nn = (tid >> 3) + 64 * j; const LAS float* s = T0 + (8 * c8) * 256 + ((((nn >> 2) ^ c8) << 2) | (nn & 3));
              v4u o; o.x = pk2(s[0 * 256], s[1 * 256]); o.y = pk2(s[2 * 256], s[3 * 256]); o.z = pk2(s[4 * 256], s[5 * 256]); o.w = pk2(s[6 * 256], s[7 * 256]);
              *(v4u*)(cur.WT + (size_t)(cur.n0 + nn) * cur.K + cur.k0 + 8 * c8) = o; } }
        __syncthreads();
    }
}
__device__ __forceinline__ void phase_prologue(KP p, GAS unsigned char* ws, LAS unsigned char* lds, int bid, int G, int gw, int NGW, int wave, int lane, int tid) {
    {   int it = bid; SqD cur, nxt; f32x4 v[16];
        if (it < SQ_PRO) { cur = sq_desc(p, ws, SQ_MAP(it)); sq_load(cur, v, tid); }
        while (it < SQ_PRO) {
            { const int kr = tid >> 3, ch = tid & 7;
#pragma unroll
              for (int i = 0; i < 16; ++i) { const int k = 64 * i + kr; const float s = cur.wn[k]; LAS unsigned short* d = (LAS unsigned short*)(lds + (4 * ch) * 2048 + (((k >> 3) ^ ch) << 4) + 2 * (k & 7));
#pragma unroll
                  for (int e = 0; e < 4; ++e) d[e * 1024] = (unsigned short)f2bf(v[i][e] * s);
                  if ((i & 1) == 1) asm volatile("s_waitcnt lgkmcnt(0)" ::: "memory"); } }
            __syncthreads();
            const int itn = it + G;
            if (itn < SQ_PRO) { nxt = sq_desc(p, ws, SQ_MAP(itn)); sq_load(nxt, v, tid); }
#pragma unroll
            for (int j = 0; j < 4; ++j) { const int row = 4 * wave + j; const LAS unsigned char* src = lds + row * 2048; float a[8], b2[8];
                unpack8(*(const LAS v4u*)(src + ((lane ^ wave) << 4)), a); unpack8(*(const LAS v4u*)(src + (((64 + lane) ^ wave) << 4)), b2);
                const float mx = absmax16(a, b2), step = mx > 0.f ? mx * (1.0f / 127.0f) : 1.0f, inv = 1.0f / step;
                unsigned char* qd = cur.Q + (size_t)(cur.dr0 + row) * DM;
                ((v2u*)qd)[lane] = q8_pack8(a, inv); ((v2u*)(qd + 512))[lane] = q8_pack8(b2, inv);
                if (lane == 0) cur.QS[cur.dr0 + row] = step; }
            __syncthreads();
            it = itn; cur = nxt;
        }
    }
    {   LAS float* T0 = (LAS float*)lds;
        int it = bid; TrD cur, nxt; f32x4 v[8];
        if (it < TR_PRO) { cur = tr_desc(p, ws, it); tr_load(cur, v, tid); }
        while (it < TR_PRO) {
            { const int r = tid >> 6, ch = tid & 63;
#pragma unroll
              for (int i = 0; i < 8; ++i) { const int k = 8 * i + r; const float s = cur.wn ? cur.wn[cur.k0 + k] * cur.sc : cur.sc; *(LAS f32x4*)(T0 + k * 256 + ((ch ^ (i & 7)) << 2)) = v[i] * s; } }
            __syncthreads();
            const int itn = it + G;
            if (itn < TR_PRO) { nxt = tr_desc(p, ws, itn); tr_load(nxt, v, tid); }
            { const int c = tid & 7;
#pragma unroll
              for (int j = 0; j < 4; ++j) { const int nn = (tid >> 3) + 64 * j; const LAS float* s = T0 + (8 * c) * 256 + ((((nn >> 2) ^ c) << 2) | (nn & 3));
                  v4u o; o.x = pk2(s[0 * 256], s[1 * 256]); o.y = pk2(s[2 * 256], s[3 * 256]); o.z = pk2(s[4 * 256], s[5 * 256]); o.w = pk2(s[6 * 256], s[7 * 256]);
                  const int n = cur.n0 + nn; int dr = n; if (cur.mode == 1) { const int jj = n >= FF ? n - FF : n; dr = (jj / 128) * 256 + (jj % 128) + (n >= FF ? 128 : 0); }
                  *(v4u*)(cur.WT + (size_t)dr * cur.K + cur.k0 + 8 * c) = o; } }
            __syncthreads();
            it = itn; cur = nxt;
        }
    }
    { const float* x = ((const float*)(GAS const float*)p->in[0]); bf16* H = (bf16*)(ws + WS_H); float* SSQ = (float*)(ws + WS_SSQ); unsigned char* HQ = (unsigned char*)(ws + AR_Y); float* RSC0 = (float*)(ws + WS_MOEI + MI_RSC0);
      for (int m = gw; m < T; m += NGW) { const f32x4* xr = (const f32x4*)(x + (size_t)m * DM) + lane; float s = 0.f, mx = 0.f; float hv[4][4];
#pragma unroll
          for (int j = 0; j < 4; ++j) { const f32x4 v = xr[64 * j]; const unsigned w0 = pk2(v[0], v[1]), w1 = pk2(v[2], v[3]);
              hv[j][0] = bflo(w0); hv[j][1] = bfhi(w0); hv[j][2] = bflo(w1); hv[j][3] = bfhi(w1);
#pragma unroll
              for (int e = 0; e < 4; ++e) { s += hv[j][e] * hv[j][e]; mx = fmaxf(mx, fabsf(hv[j][e])); }
              ((unsigned long long*)(H + (size_t)m * DM))[lane + 64 * j] = (unsigned long long)w0 | ((unsigned long long)w1 << 32); }
          s = wave_sum(s); mx = wave_max(mx); if (lane < 16) SSQ[(size_t)m * 16 + lane] = lane == 0 ? s : 0.f;
          const float step = mx > 0.f ? mx * (1.0f / 127.0f) : 1.0f, inv = 1.0f / step;
#pragma unroll
          for (int j = 0; j < 4; ++j) { unsigned q = 0u;
#pragma unroll
              for (int e = 0; e < 4; ++e) q |= ((unsigned)(int)__builtin_rintf(hv[j][e] * inv) & 0xffu) << (8 * e);
              ((unsigned*)(HQ + (size_t)m * DM))[lane + 64 * j] = q; }
          if (lane == 0) RSC0[m] = step / sqrtf(s * (1.0f / DM) + NORM_EPS); } }
    { const float* mem = ((const float*)(GAS const float*)p->in[1]); const float* w = ((const float*)(GAS const float*)p->in[16]); bf16* MN = (bf16*)(ws + WS_MEMN);
      for (int m = gw; m < MROWS; m += NGW) { const f32x4* xr = (const f32x4*)(mem + (size_t)m * DM) + lane; f32x4 v[4]; float s = 0.f;
#pragma unroll
          for (int j = 0; j < 4; ++j) { v[j] = xr[64 * j]; s += (v[j][0] * v[j][0] + v[j][1] * v[j][1]) + (v[j][2] * v[j][2] + v[j][3] * v[j][3]); }
          const float rs = 1.0f / sqrtf(wave_sum(s) * (1.0f / DM) + NORM_EPS);
#pragma unroll
          for (int j = 0; j < 4; ++j) { const f32x4 g = ((const f32x4*)w)[lane + 64 * j]; const unsigned w0 = pk2(v[j][0] * rs * g[0], v[j][1] * rs * g[1]), w1 = pk2(v[j][2] * rs * g[2], v[j][3] * rs * g[3]);
              ((unsigned long long*)(MN + (size_t)m * DM))[lane + 64 * j] = (unsigned long long)w0 | ((unsigned long long)w1 << 32); } } }
    { bf16* WQN = (bf16*)(ws + WS_WCQ); const float sc = 0.0625f * 1.4426950408889634f;
      for (size_t i8 = (size_t)gw * 64 + lane; i8 < (size_t)NL * DM * DM / 8; i8 += (size_t)NGW * 64) { const size_t e0 = i8 * 8; const int l = (int)(e0 / ((size_t)DM * DM)), k = (int)((e0 / DM) % DM);
          const f32x4 a = *(const f32x4*)(((const float*)(GAS const float*)p->in[17]) + e0), b2 = *(const f32x4*)(((const float*)(GAS const float*)p->in[17]) + e0 + 4); const float s = ((const float*)(GAS const float*)p->in[15])[l * DM + k] * sc;
          v4u o; o.x = pk2(a[0] * s, a[1] * s); o.y = pk2(a[2] * s, a[3] * s); o.z = pk2(b2[0] * s, b2[1] * s); o.w = pk2(b2[2] * s, b2[3] * s); *(v4u*)(WQN + e0) = o; } }
    { float* ROPE = (float*)(ws + WS_ROPE);
      for (int idx = gw * 64 + lane; idx < SEQ * 32; idx += NGW * 64) { const int pos = idx >> 5, i = idx & 31; const float invf = (float)pow(10000.0, -(double)i / 32.0); const float ang = (float)pos * invf;
          ROPE[2 * idx] = (float)cos((double)ang); ROPE[2 * idx + 1] = (float)sin((double)ang); }
      float* WR = (float*)(ws + WS_WR);
      for (int idx = gw * 64 + lane; idx < 2 * DM * NEXP; idx += NGW * 64) { const int i = idx / (DM * NEXP), k = (idx / NEXP) % DM; WR[idx] = ((const float*)(GAS const float*)p->in[23])[idx] * ((const float*)(GAS const float*)p->in[20])[(2 * i + 1) * DM + k]; } }
}


typedef short s16x8 __attribute__((ext_vector_type(8)));
typedef short s16x4 __attribute__((ext_vector_type(4)));
typedef _Float16 h16x8 __attribute__((ext_vector_type(8)));
typedef float f32x16 __attribute__((ext_vector_type(16)));
constexpr int AT_KSTR = 144, AT_VSTR = 136;
constexpr int AT_KS = 0, AT_VS = 2 * 64 * AT_KSTR, AT_FLAG = AT_VS + 2 * 64 * AT_VSTR, AT_SIN = AT_FLAG + 64, AT_UNIT = MISC_OFF + 64;
constexpr int RS_STR = 520, RS_KT = 0, RS_VT = 64 * RS_STR;
constexpr unsigned RS_UNITS = 64 * 7;
__device__ __forceinline__ int crow(int reg, int h) { return (reg & 3) + 8 * (reg >> 2) + 4 * h; }
__device__ __forceinline__ unsigned cvtpk_bf16(float lo, float hi) { unsigned r; asm volatile("v_cvt_pk_bf16_f32 %0, %1, %2" : "=v"(r) : "v"(lo), "v"(hi)); return r; }

template <int MODE>
__device__ __forceinline__ void attn_unit(const bf16* PROJ, bf16* Y, const float* ROPE, const float* gain, const float* SLOC, unsigned* ctrA, int bh, int qb, LAS unsigned char* lds, int wave, int lane, int tid) {
    constexpr int NH = MODE == 0 ? 8 : 4, QCOL = MODE == 0 ? O_SB : O_RET, KCOL = QCOL + (MODE == 0 ? 512 : 256), VCOL = KCOL + (MODE == 0 ? 512 : 256), YCOL = MODE == 0 ? 512 : 256;
    const int b = bh / NH, hd = bh % NH, r = lane & 31, h = lane >> 5;
    const int n0 = qb * 256 + wave * 32;
    const size_t rowb = (size_t)b * SEQ;
    s16x8 qf[4];
    { const bf16* qp = PROJ + (rowb + n0 + r) * INC + QCOL + hd * 64;
      float q[4][8];
#pragma unroll
      for (int s = 0; s < 4; ++s) unpack8(*(const v4u*)(qp + 16 * s + 8 * h), q[s]);
      if (MODE == 1) { const float* rp = ROPE + (size_t)(n0 + r) * 64;
#pragma unroll
          for (int s = 0; s < 2; ++s)
#pragma unroll
              for (int j = 0; j < 8; ++j) { const int i = 16 * s + 8 * h + j; const float cs = rp[2 * i], sn = rp[2 * i + 1]; const float x1 = q[s][j], x2 = q[s + 2][j]; q[s][j] = x1 * cs - x2 * sn; q[s + 2][j] = x1 * sn + x2 * cs; } }
      const float qs = MODE == 0 ? 0.125f * 1.4426950408889634f : 0.125f;
#pragma unroll
      for (int s = 0; s < 4; ++s) { v4u w; w.x = cvtpk_bf16(q[s][0] * qs, q[s][1] * qs); w.y = cvtpk_bf16(q[s][2] * qs, q[s][3] * qs); w.z = cvtpk_bf16(q[s][4] * qs, q[s][5] * qs); w.w = cvtpk_bf16(q[s][6] * qs, q[s][7] * qs); qf[s] = __builtin_bit_cast(s16x8, w); } }
    h16x8 uf[2];
    float dl[16]; float lg = 0.f;
    if (MODE == 0) {
#pragma unroll
        for (int s = 0; s < 2; ++s)
#pragma unroll
            for (int j = 0; j < 8; ++j) uf[s][j] = (16 * s + 8 * (j >> 2) + 4 * h + (j & 3)) >= r ? (_Float16)1.0f : (_Float16)0.0f;
    } else { lg = log2f(1.0f - exp2f(-5.0f - (float)hd));
#pragma unroll
        for (int i = 0; i < 16; ++i) dl[i] = exp2f(lg * (float)(r - crow(i, h))); }
    f32x16 o0, o1;
#pragma unroll
    for (int i = 0; i < 16; ++i) { o0[i] = 0.f; o1[i] = 0.f; }
    if (MODE == 1 && qb > 0) {
        if (tid == 0) { unsigned sp = 0; while (__hip_atomic_load(ctrA, __ATOMIC_RELAXED, __HIP_MEMORY_SCOPE_AGENT) < RS_UNITS) { __builtin_amdgcn_s_sleep(2); if (++sp > (1u << 22)) break; }
            __builtin_amdgcn_fence(__ATOMIC_ACQUIRE, "agent"); asm volatile("s_waitcnt vmcnt(0)" ::: "memory"); }
        __syncthreads();
        { float acc8[8];
#pragma unroll
          for (int j = 0; j < 8; ++j) acc8[j] = 0.f;
          const float g256 = exp2f(lg * 256.0f);
          for (int j = 0; j < qb; ++j) { const f32x4* sp4 = (const f32x4*)(SLOC + ((size_t)(bh * 7 + j) * 4096 + tid * 8)); const f32x4 s0 = sp4[0], s1 = sp4[1];
#pragma unroll
              for (int e = 0; e < 4; ++e) { acc8[e] = acc8[e] * g256 + s0[e]; acc8[4 + e] = acc8[4 + e] * g256 + s1[e]; } }
          v4u w; w.x = cvtpk_bf16(acc8[0], acc8[1]); w.y = cvtpk_bf16(acc8[2], acc8[3]); w.z = cvtpk_bf16(acc8[4], acc8[5]); w.w = cvtpk_bf16(acc8[6], acc8[7]);
          *(LAS v4u*)(lds + AT_SIN + (tid >> 3) * AT_KSTR + (tid & 7) * 16) = w; }
        __syncthreads();
        const LAS unsigned char* sb = lds + AT_SIN + r * AT_KSTR + 16 * h;
#pragma unroll
        for (int s = 0; s < 4; ++s) { const s16x8 a0 = *(const LAS s16x8*)(sb + 32 * s), a1 = *(const LAS s16x8*)(sb + 32 * AT_KSTR + 32 * s);
            o0 = __builtin_amdgcn_mfma_f32_32x32x16_bf16(a0, qf[s], o0, 0, 0, 0); o1 = __builtin_amdgcn_mfma_f32_32x32x16_bf16(a1, qf[s], o1, 0, 0, 0); }
        const float rsc = exp2f(lg * (float)(32 * wave + r + 1));
#pragma unroll
        for (int i = 0; i < 16; ++i) { o0[i] *= rsc; o1[i] *= rsc; }
    }
    float carry = 0.f; bool wdone = false;
    const int st_row = (tid & 255) >> 2, st_c = tid & 3; const bool st_k = tid < 256;
    const int kt_first = 4 * qb + 3, kt_lo = MODE == 1 ? 4 * qb : 0;
    struct SR { v4u g0, g1; f32x4 rp4[4]; };
    auto stage_load = [&](int kt, SR& R) { const bf16* src = PROJ + (rowb + 64 * kt + st_row) * INC + (st_k ? KCOL : VCOL) + hd * 64 + 8 * st_c; R.g0 = *(const v4u*)src; R.g1 = *(const v4u*)(src + 32);
        if (MODE == 1 && st_k) { const f32x4* rq = (const f32x4*)(ROPE + (size_t)(64 * kt + st_row) * 64 + 16 * st_c);
#pragma unroll
            for (int j = 0; j < 4; ++j) R.rp4[j] = rq[j]; } };
    auto stage_store = [&](int buf, SR& R) {
        v4u g0 = R.g0, g1 = R.g1;
        if (st_k) {
            if (MODE == 1) { float a[8], c2[8]; unpack8(g0, a); unpack8(g1, c2);
#pragma unroll
                for (int j = 0; j < 8; ++j) { const float cs = R.rp4[j >> 1][2 * (j & 1)], sn = R.rp4[j >> 1][2 * (j & 1) + 1]; const float x1 = a[j], x2 = c2[j]; a[j] = x1 * cs - x2 * sn; c2[j] = x1 * sn + x2 * cs; }
                g0.x = cvtpk_bf16(a[0], a[1]); g0.y = cvtpk_bf16(a[2], a[3]); g0.z = cvtpk_bf16(a[4], a[5]); g0.w = cvtpk_bf16(a[6], a[7]);
                g1.x = cvtpk_bf16(c2[0], c2[1]); g1.y = cvtpk_bf16(c2[2], c2[3]); g1.z = cvtpk_bf16(c2[4], c2[5]); g1.w = cvtpk_bf16(c2[6], c2[7]); }
            LAS unsigned char* d = lds + AT_KS + buf * 64 * AT_KSTR + st_row * AT_KSTR + 16 * st_c; *(LAS v4u*)d = g0; *(LAS v4u*)(d + 64) = g1;
        } else {
            LAS unsigned short* d = (LAS unsigned short*)(lds + AT_VS + buf * 64 * AT_VSTR + (8 * st_c) * AT_VSTR + 2 * st_row);
            const unsigned w0[4] = {g0.x, g0.y, g0.z, g0.w}, w1[4] = {g1.x, g1.y, g1.z, g1.w};
#pragma unroll
            for (int j = 0; j < 4; ++j) { d[(2 * j) * (AT_VSTR / 2)] = (unsigned short)(w0[j] & 0xffffu); d[(2 * j + 1) * (AT_VSTR / 2)] = (unsigned short)(w0[j] >> 16);
                d[(32 + 2 * j) * (AT_VSTR / 2)] = (unsigned short)(w1[j] & 0xffffu); d[(32 + 2 * j + 1) * (AT_VSTR / 2)] = (unsigned short)(w1[j] >> 16);
                if (j & 1) asm volatile("s_waitcnt lgkmcnt(0)" ::: "memory"); }
        } };
    LAS unsigned* flags = (LAS unsigned*)(lds + AT_FLAG);
    SR RA, RB;
    stage_load(kt_first, RA); stage_store(0, RA);
    stage_load(kt_first - 1, RA);
    __syncthreads();
    auto compute = [&](int kt, int buf) {
        if (!wdone) {
#pragma unroll
            for (int sub = 1; sub >= 0; --sub) {
                const int k0 = 64 * kt + 32 * sub;
                if (k0 <= n0) {
                    const bool diag = (k0 == n0);
                    const LAS unsigned char* kb = lds + AT_KS + buf * 64 * AT_KSTR + (32 * sub + r) * AT_KSTR + 16 * h;
                    f32x16 st;
#pragma unroll
                    for (int i = 0; i < 16; ++i) st[i] = 0.f;
#pragma unroll
                    for (int s = 0; s < 4; ++s) { const s16x8 kf = *(const LAS s16x8*)(kb + 32 * s); st = __builtin_amdgcn_mfma_f32_32x32x16_bf16(kf, qf[s], st, 0, 0, 0); }
                    float w[16];
                    if (MODE == 0) {
                        float sp[16];
#pragma unroll
                        for (int i = 0; i < 16; ++i) { const float z = st[i]; const float t = __builtin_amdgcn_exp2f(-fabsf(z)); sp[i] = __builtin_fmaf(0.5f, z, __builtin_fmaf(0.5f, fabsf(z), __builtin_amdgcn_logf(1.0f + t))); }
                        if (diag) {
#pragma unroll
                            for (int i = 0; i < 16; ++i) if (!(crow(i, h) < r)) sp[i] = 0.f; }
                        const float z0 = st[0];
                        f32x16 af = st;
#pragma unroll
                        for (int s = 0; s < 2; ++s) { h16x8 lf;
#pragma unroll
                            for (int j = 0; j < 8; ++j) lf[j] = (_Float16)(-sp[8 * s + j]);
                            af = __builtin_amdgcn_mfma_f32_32x32x16_f16(uf[s], lf, af, 0, 0, 0); }
#pragma unroll
                        for (int i = 0; i < 16; ++i) w[i] = __builtin_amdgcn_exp2f(af[i] + carry);
                        if (diag) {
#pragma unroll
                            for (int i = 0; i < 16; ++i) if (!(crow(i, h) < r)) w[i] = 0.f; }
                        const float c0 = af[0] - z0; const float cp = __shfl_xor(c0, 32); carry += h ? cp : c0;
                    } else {
                        const float ts = exp2f(lg * (float)(n0 - k0));
#pragma unroll
                        for (int i = 0; i < 16; ++i) w[i] = st[i] * (dl[i] * ts);
                        if (diag) {
#pragma unroll
                            for (int i = 0; i < 16; ++i) if (!(crow(i, h) <= r)) w[i] = 0.f; }
                    }
                    s16x8 pf[2];
#pragma unroll
                    for (int s = 0; s < 2; ++s) { v4u pw; pw.x = cvtpk_bf16(w[8 * s], w[8 * s + 1]); pw.y = cvtpk_bf16(w[8 * s + 2], w[8 * s + 3]); pw.z = cvtpk_bf16(w[8 * s + 4], w[8 * s + 5]); pw.w = cvtpk_bf16(w[8 * s + 6], w[8 * s + 7]); pf[s] = __builtin_bit_cast(s16x8, pw); }
                    const LAS unsigned char* vb = lds + AT_VS + buf * 64 * AT_VSTR + r * AT_VSTR + (32 * sub + 4 * h) * 2;
#pragma unroll
                    for (int s = 0; s < 2; ++s) {
                        const s16x4 a0 = *(const LAS s16x4*)(vb + 32 * s), a1 = *(const LAS s16x4*)(vb + 32 * s + 16);
                        const s16x4 b0 = *(const LAS s16x4*)(vb + 32 * AT_VSTR + 32 * s), b1 = *(const LAS s16x4*)(vb + 32 * AT_VSTR + 32 * s + 16);
                        const s16x8 v0 = __builtin_shufflevector(a0, a1, 0, 1, 2, 3, 4, 5, 6, 7), v1 = __builtin_shufflevector(b0, b1, 0, 1, 2, 3, 4, 5, 6, 7);
                        o0 = __builtin_amdgcn_mfma_f32_32x32x16_bf16(v0, pf[s], o0, 0, 0, 0); o1 = __builtin_amdgcn_mfma_f32_32x32x16_bf16(v1, pf[s], o1, 0, 0, 0); }
                }
            }
            if (MODE == 0 && __all(carry < -152.0f)) wdone = true;
        }
    };
    auto post = [&](int par) { if (MODE == 0 && lane == 0) flags[8 * par + wave] = wdone ? 1u : 0u; };
    auto all_done = [&](int par) -> bool { if (MODE != 0) return false; const v4u f0 = *(const LAS v4u*)(flags + 8 * par), f1 = *(const LAS v4u*)(flags + 8 * par + 4); return (f0.x & f0.y & f0.z & f0.w & f1.x & f1.y & f1.z & f1.w) != 0u; };
#define LBAR() do { asm volatile("s_waitcnt lgkmcnt(0)" ::: "memory"); __builtin_amdgcn_s_barrier(); asm volatile("" ::: "memory"); } while (0)
    for (int kt = kt_first; kt >= kt_lo + 1; kt -= 2) {
        if (kt - 2 >= kt_lo) stage_load(kt - 2, RB);
        compute(kt, 0);
        stage_store(1, RA);
        post(0);
        LBAR();
        if (all_done(0)) break;
        if (kt - 3 >= kt_lo) stage_load(kt - 3, RA);
        compute(kt - 1, 1);
        if (kt - 2 >= kt_lo) stage_store(0, RB);
        post(1);
        LBAR();
        if (all_done(1)) break;
    }
#undef LBAR
    bf16* yo = Y + (rowb + n0 + r) * DM + YCOL + hd * 64;
    if (MODE == 0) {
#pragma unroll
        for (int g = 0; g < 4; ++g) { v2u a; a.x = cvtpk_bf16(o0[4 * g], o0[4 * g + 1]); a.y = cvtpk_bf16(o0[4 * g + 2], o0[4 * g + 3]); *(v2u*)(yo + 8 * g + 4 * h) = a;
            v2u c; c.x = cvtpk_bf16(o1[4 * g], o1[4 * g + 1]); c.y = cvtpk_bf16(o1[4 * g + 2], o1[4 * g + 3]); *(v2u*)(yo + 32 + 8 * g + 4 * h) = c; }
    } else {
        float s = 0.f;
#pragma unroll
        for (int i = 0; i < 16; ++i) s += o0[i] + o1[i];
        s += __shfl_xor(s, 32); const float mu = s * (1.0f / 64.0f); float q2 = 0.f;
#pragma unroll
        for (int i = 0; i < 16; ++i) { const float e0 = o0[i] - mu, e1 = o1[i] - mu; q2 += e0 * e0 + e1 * e1; }
        q2 += __shfl_xor(q2, 32); const float rs = 1.0f / sqrtf(q2 * (1.0f / 64.0f) + 1e-6f);
        const bf16* gp = PROJ + (rowb + n0 + r) * INC + O_RET + 768 + hd * 64;
#pragma unroll
        for (int g = 0; g < 4; ++g)
#pragma unroll
            for (int db = 0; db < 2; ++db) { const int d = 32 * db + 8 * g + 4 * h; const v2u gv = *(const v2u*)(gp + d); const f32x4 gn = *(const f32x4*)(gain + hd * 64 + d);
                const float gg[4] = {bflo(gv.x), bfhi(gv.x), bflo(gv.y), bfhi(gv.y)}; float ov[4];
#pragma unroll
                for (int j = 0; j < 4; ++j) { const float x = db ? o1[4 * g + j] : o0[4 * g + j]; ov[j] = (x - mu) * rs * gn[j] * (gg[j] * __builtin_amdgcn_rcpf(1.0f + __expf(-gg[j]))); }
                v2u a; a.x = cvtpk_bf16(ov[0], ov[1]); a.y = cvtpk_bf16(ov[2], ov[3]); *(v2u*)(yo + d) = a; }
    }
    __syncthreads();
}

__device__ __forceinline__ void ret_state_unit(const bf16* PROJ, const float* ROPE, float* SLOC, unsigned* ctrA, int bh, int qb, LAS unsigned char* lds, int wave, int lane, int tid) {
    const int b = bh >> 2, hd = bh & 3, r = lane & 31, h = lane >> 5; const size_t rowb = (size_t)b * SEQ;
    const int st_row = (tid & 255) >> 2, st_c = tid & 3; const bool st_k = tid < 256;
    const float lg = log2f(1.0f - exp2f(-5.0f - (float)hd));
    v4u g0[4], g1[4]; f32x4 rp4[4][4];
#pragma unroll
    for (int t = 0; t < 4; ++t) { const int key = 256 * qb + 64 * t + st_row; const bf16* src = PROJ + (rowb + key) * INC + O_RET + (st_k ? 256 : 512) + hd * 64 + 8 * st_c; g0[t] = *(const v4u*)src; g1[t] = *(const v4u*)(src + 32);
        if (st_k) { const f32x4* rq = (const f32x4*)(ROPE + (size_t)key * 64 + 16 * st_c);
#pragma unroll
            for (int j = 0; j < 4; ++j) rp4[t][j] = rq[j]; } }
#pragma unroll
    for (int t = 0; t < 4; ++t) { const int jl = 64 * t + st_row;
        float a[8], c2[8]; unpack8(g0[t], a); unpack8(g1[t], c2);
        if (st_k) { const float zeta = exp2f(lg * (float)(255 - jl));
#pragma unroll
            for (int j = 0; j < 8; ++j) { const float cs = rp4[t][j >> 1][2 * (j & 1)], sn = rp4[t][j >> 1][2 * (j & 1) + 1]; const float x1 = a[j], x2 = c2[j]; a[j] = (x1 * cs - x2 * sn) * zeta; c2[j] = (x1 * sn + x2 * cs) * zeta; } }
        LAS unsigned short* d = (LAS unsigned short*)(lds + (st_k ? RS_KT : RS_VT) + (8 * st_c) * RS_STR + 2 * jl);
#pragma unroll
        for (int j = 0; j < 8; j += 2) { const unsigned p0 = cvtpk_bf16(a[j], a[j + 1]), p1 = cvtpk_bf16(c2[j], c2[j + 1]);
            d[j * (RS_STR / 2)] = (unsigned short)(p0 & 0xffffu); d[(j + 1) * (RS_STR / 2)] = (unsigned short)(p0 >> 16);
            d[(32 + j) * (RS_STR / 2)] = (unsigned short)(p1 & 0xffffu); d[(32 + j + 1) * (RS_STR / 2)] = (unsigned short)(p1 >> 16);
            if (j & 2) asm volatile("s_waitcnt lgkmcnt(0)" ::: "memory"); } }
    __syncthreads();
    if (wave < 4) { const int ba = wave >> 1, bb = wave & 1;
        f32x16 acc;
#pragma unroll
        for (int i = 0; i < 16; ++i) acc[i] = 0.f;
        const LAS unsigned char* va = lds + RS_VT + (32 * ba + r) * RS_STR + 16 * h; const LAS unsigned char* ka = lds + RS_KT + (32 * bb + r) * RS_STR + 16 * h;
#pragma unroll
        for (int s = 0; s < 16; ++s) { const s16x4 v0 = *(const LAS s16x4*)(va + 32 * s), v1 = *(const LAS s16x4*)(va + 32 * s + 8), k0 = *(const LAS s16x4*)(ka + 32 * s), k1 = *(const LAS s16x4*)(ka + 32 * s + 8);
            acc = __builtin_amdgcn_mfma_f32_32x32x16_bf16(__builtin_shufflevector(v0, v1, 0, 1, 2, 3, 4, 5, 6, 7), __builtin_shufflevector(k0, k1, 0, 1, 2, 3, 4, 5, 6, 7), acc, 0, 0, 0); }
        float* dst = SLOC + (size_t)(bh * 7 + qb) * 4096 + 32 * bb + r;
#pragma unroll
        for (int i = 0; i < 16; ++i) dst[(size_t)(32 * ba + crow(i, h)) * 64] = acc[i];
    }
    asm volatile("s_waitcnt vmcnt(0)" ::: "memory");
    __syncthreads();
    if (tid == 0) { __builtin_amdgcn_fence(__ATOMIC_RELEASE, "agent"); asm volatile("s_waitcnt vmcnt(0)" ::: "memory"); __hip_atomic_fetch_add(ctrA, 1u, __ATOMIC_RELAXED, __HIP_MEMORY_SCOPE_AGENT); }
    __syncthreads();
}


constexpr int S5_BUSTR = 132 * 4, S5_XSTR = 272, S5_WAVE = 16 * S5_BUSTR + 16 * S5_XSTR, S5_E = 8 * S5_WAVE;
__device__ __forceinline__ void s5_unit(KP p, int l, const bf16* PROJ, bf16* GBo, int bg, LAS unsigned char* lds, int wave, int lane) {
    const int b = bg >> 4, g = bg & 15, lq = lane >> 4, lr = lane & 15; const size_t rowb = (size_t)b * SEQ;
    const int gq = (l * 16 + g) * 64;
    const float dt = expf(((const float*)(GAS const float*)p->in[11])[l * 16 + g]);
    float are, aim;
    { const float lre = ((const float*)(GAS const float*)p->in[4])[gq + lane], lim = ((const float*)(GAS const float*)p->in[5])[gq + lane]; const float mag = expf(lre * dt); are = mag * cosf(lim * dt); aim = mag * sinf(lim * dt); }
    float pr = are, pi = aim;
#pragma unroll
    for (int k = 0; k < 8; ++k) { const float nr = pr * pr - pi * pi, ni = 2.0f * pr * pi; pr = nr; pi = ni; }
    s16x8 bbf[8];
#pragma unroll
    for (int q4 = 0; q4 < 4; ++q4) { const int pp = 16 * q4 + lr; const float lre = ((const float*)(GAS const float*)p->in[4])[gq + pp], lim = ((const float*)(GAS const float*)p->in[5])[gq + pp]; const float mag = expf(lre * dt), ar = mag * cosf(lim * dt), ai = mag * sinf(lim * dt);
        const float den = lre * lre + lim * lim, nr = ar - 1.0f, zre = (nr * lre + ai * lim) / den, zim = (ai * lre - nr * lim) / den;
        const float msk = lq < 2 ? 1.0f : 0.0f; const int hb = 8 * (lq & 1);
        const f32x4 r0 = *(const f32x4*)(((const float*)(GAS const float*)p->in[6]) + (size_t)(gq + pp) * 16 + hb), r1 = *(const f32x4*)(((const float*)(GAS const float*)p->in[6]) + (size_t)(gq + pp) * 16 + hb + 4);
        const f32x4 i0 = *(const f32x4*)(((const float*)(GAS const float*)p->in[7]) + (size_t)(gq + pp) * 16 + hb), i1 = *(const f32x4*)(((const float*)(GAS const float*)p->in[7]) + (size_t)(gq + pp) * 16 + hb + 4);
        float br[8] = {r0[0], r0[1], r0[2], r0[3], r1[0], r1[1], r1[2], r1[3]}, bi[8] = {i0[0], i0[1], i0[2], i0[3], i1[0], i1[1], i1[2], i1[3]}; float vr[8], vi[8];
#pragma unroll
        for (int j = 0; j < 8; ++j) { vr[j] = (zre * br[j] - zim * bi[j]) * msk; vi[j] = (zre * bi[j] + zim * br[j]) * msk; }
        v4u wr_, wi_; wr_.x = cvtpk_bf16(vr[0], vr[1]); wr_.y = cvtpk_bf16(vr[2], vr[3]); wr_.z = cvtpk_bf16(vr[4], vr[5]); wr_.w = cvtpk_bf16(vr[6], vr[7]);
        wi_.x = cvtpk_bf16(vi[0], vi[1]); wi_.y = cvtpk_bf16(vi[2], vi[3]); wi_.z = cvtpk_bf16(vi[4], vi[5]); wi_.w = cvtpk_bf16(vi[6], vi[7]);
        bbf[q4] = __builtin_bit_cast(s16x8, wr_); bbf[q4 + 4] = __builtin_bit_cast(s16x8, wi_); }
    s16x8 cf[4];
#pragma unroll
    for (int s = 0; s < 4; ++s) { const size_t co = ((size_t)(l * 16 + g) * 16 + lr) * 64 + 16 * s + 4 * lq;
        const f32x4 cr = *(const f32x4*)(((const float*)(GAS const float*)p->in[8]) + co), ci = *(const f32x4*)(((const float*)(GAS const float*)p->in[9]) + co);
        v4u w; w.x = cvtpk_bf16(cr[0], -ci[0]); w.y = cvtpk_bf16(cr[1], -ci[1]); w.z = cvtpk_bf16(cr[2], -ci[2]); w.w = cvtpk_bf16(cr[3], -ci[3]); cf[s] = __builtin_bit_cast(s16x8, w); }
    s16x8 dfrag;
    { const float dsk = ((const float*)(GAS const float*)p->in[10])[l * 256 + g * 16 + lr]; const unsigned short db = (unsigned short)f2bf(dsk);
#pragma unroll
      for (int j = 0; j < 8; ++j) dfrag[j] = (lq < 2 && 8 * lq + j == lr) ? (short)db : (short)0; }
    const bf16* usrc = PROJ + (rowb + 256 * wave + lr) * INC + g * 16 + 8 * (lq & 1);
    LAS float* BU = (LAS float*)(lds + wave * S5_WAVE); LAS unsigned char* XB = lds + wave * S5_WAVE + 16 * S5_BUSTR; LAS float* EB = (LAS float*)(lds + S5_E);
    const __amdgpu_buffer_rsrc_t gbrs = __builtin_amdgcn_make_buffer_rsrc((void*)GBo, 0, 0x7fffffff, 0x00020000);
    LAS unsigned char* SG = lds + (wave < 6 ? S5_E + 4096 + 4096 * wave : TAB_OFF + 4096 * (wave - 6));
    float xr = 0.f, xi = 0.f;
#define S5_LW() asm volatile("s_waitcnt lgkmcnt(0)" ::: "memory")
#define S5_TILE_HEAD() \
            v4u uw = uq0; uq0 = uq1; { const int tn = tile + 2 < 16 ? tile + 2 : 15; uq1 = *(const v4u*)(usrc + (size_t)(16 * tn) * INC); } \
            if (lq >= 2) { uw.x = 0u; uw.y = 0u; uw.z = 0u; uw.w = 0u; } \
            const s16x8 uf = __builtin_bit_cast(s16x8, uw); \
            _Pragma("unroll") for (int cb = 0; cb < 8; ++cb) { f32x4 acc = {0.f, 0.f, 0.f, 0.f}; acc = __builtin_amdgcn_mfma_f32_16x16x32_bf16(uf, bbf[cb], acc, 0, 0, 0); \
                _Pragma("unroll") for (int rg = 0; rg < 4; ++rg) BU[(4 * lq + rg) * 132 + 16 * cb + lr] = acc[rg]; \
                if ((cb & 3) == 3) S5_LW(); } \
            float bur[16], bui[16]; \
            _Pragma("unroll") for (int tt = 0; tt < 16; ++tt) { bur[tt] = BU[tt * 132 + lane]; bui[tt] = BU[tt * 132 + 64 + lane]; if ((tt & 7) == 7) S5_LW(); }
    { v4u uq0 = *(const v4u*)usrc, uq1 = *(const v4u*)(usrc + (size_t)16 * INC);
#pragma unroll 1
      for (int tile = 0; tile < 16; ++tile) {
            S5_TILE_HEAD()
#pragma unroll
            for (int tt = 0; tt < 16; ++tt) { const float nxr = are * xr - aim * xi + bur[tt], nxi = are * xi + aim * xr + bui[tt]; xr = nxr; xi = nxi; }
      } }
    { EB[wave * 128 + lane] = xr; EB[wave * 128 + 64 + lane] = xi;
      __syncthreads();
      float cr = 0.f, ci = 0.f;
      for (int w2 = 0; w2 < wave; ++w2) { const float er = EB[w2 * 128 + lane], ei = EB[w2 * 128 + 64 + lane]; const float nr = pr * cr - pi * ci + er, ni = pr * ci + pi * cr + ei; cr = nr; ci = ni; }
      xr = cr; xi = ci; }
    { v4u uq0 = *(const v4u*)usrc, uq1 = *(const v4u*)(usrc + (size_t)16 * INC);
#pragma unroll 1
      for (int tile = 0; tile < 16; ++tile) {
            S5_TILE_HEAD()
#pragma unroll
            for (int tt = 0; tt < 16; ++tt) { const float nxr = are * xr - aim * xi + bur[tt], nxi = are * xi + aim * xr + bui[tt]; xr = nxr; xi = nxi;
                *(LAS unsigned*)(XB + tt * S5_XSTR + 4 * lane) = cvtpk_bf16(xr, xi); if ((tt & 7) == 7) S5_LW(); }
            f32x4 ya = {0.f, 0.f, 0.f, 0.f};
#pragma unroll
            for (int s = 0; s < 4; ++s) { const s16x8 xa = *(const LAS s16x8*)(XB + lr * S5_XSTR + (32 * s + 8 * lq) * 2); ya = __builtin_amdgcn_mfma_f32_16x16x32_bf16(xa, cf[s], ya, 0, 0, 0); }
            ya = __builtin_amdgcn_mfma_f32_16x16x32_bf16(uf, dfrag, ya, 0, 0, 0);
#pragma unroll
            for (int rg = 0; rg < 4; ++rg) { const float y = ya[rg];
                const float gl = y * __builtin_amdgcn_rcpf(1.0f + __expf(-1.5957691216057308f * (y + 0.044715f * y * y * y)));
                *(LAS unsigned short*)(SG + (((tile & 7) * 16 + 4 * lq + rg) * 16 + lr) * 2) = (unsigned short)f2bf(gl); }
            if ((tile & 7) == 7) {
#pragma unroll
                for (int j = 0; j < 4; ++j) { const int c = lane + 64 * j, r = c >> 1, hf = c & 1; const v4u v = *(const LAS v4u*)(SG + r * 32 + hf * 16);
                    __builtin_amdgcn_raw_buffer_store_b128(v, gbrs, (int)(((rowb + 256 * wave + 128 * (tile >> 3) + r) * 256 + g * 16 + hf * 8) * 2), 0, 16); }
            }
      } }
#undef S5_TILE_HEAD
#undef S5_LW
    __syncthreads();
}

__global__ void __launch_bounds__(512, 2) mk_fwd(P p_arg) {
    extern __shared__ __attribute__((aligned(16))) unsigned char lds_raw[];
    LAS unsigned char* lds = (LAS unsigned char*)lds_raw;
    const int tid0 = threadIdx.x, G0 = gridDim.x, bid0 = blockIdx.x, wave0 = __builtin_amdgcn_readfirstlane(tid0 >> 6);
    const KP kp0 = (KP)__builtin_amdgcn_kernarg_segment_ptr();
    volatile LAS unsigned* MISC = (volatile LAS unsigned*)(lds + MISC_OFF);
    if (tid0 < 32) MISC[tid0] = 0u;
    __syncthreads();
#if !MK_MULTI
    XcdBarrier bar = xcd_barrier_post((unsigned*)(kp0->ws + WS_CTL), MISC + 8);
#define SEAM(k) do { if (hi > (k) + 1) xcd_barrier(bar); } while (0)
#else
#define SEAM(k) do { } while (0)
#endif
    const int lo = kp0->ph_lo, hi = kp0->ph_hi;
#define IN(k) (lo <= (k) && (k) < hi)
#define GIN(k_) ((const float*)(GAS const float*)p->in[k_])
#define PH_BEGIN KP p = kp0; asm volatile("" : "+s"(p)); GAS unsigned char* ws = (GAS unsigned char*)p->ws; asm volatile("" : "+s"(ws)); \
    int G = G0, bid = bid0, wave = wave0; asm volatile("" : "+s"(G), "+s"(bid), "+s"(wave)); \
    unsigned ones_ = ~0u; asm volatile("" : "+s"(ones_)); const int lane = (int)__builtin_amdgcn_mbcnt_hi(ones_, __builtin_amdgcn_mbcnt_lo(ones_, 0u)), tid = wave * 64 + lane, gw = bid * 8 + wave, NGW = G * 8; (void)tid; (void)gw; (void)NGW;
#define H ((bf16*)(ws + WS_H))
#define SSQ ((float*)(ws + WS_SSQ))
#define ROPE ((const float*)(ws + WS_ROPE))
#define MEMN ((bf16*)(ws + WS_MEMN))
#define KC ((bf16*)(ws + WS_KC))
#define VT ((bf16*)(ws + WS_VT))
#define PROJ ((bf16*)(ws + AR_PROJ))
#define Y ((bf16*)(ws + AR_Y))
#define GB ((bf16*)(ws + AR_G))
#define ZB ((bf16*)(ws + AR_Z))
#define XS ((float*)(ws + AR_XS))
#define QC ((bf16*)(ws + AR_QC))
#define SC ((float*)(ws + AR_SC))
#define PB ((bf16*)(ws + AR_PB))
#define OC ((bf16*)(ws + AR_OC))
#define ACT ((bf16*)(ws + AR_ACT))
#define XG ((bf16*)(ws + AR_XG))
#define ACTG ((bf16*)(ws + AR_ACTG))
#define DG ((bf16*)(ws + AR_DG))
#define CNT ((int*)(ws + WS_MOEI + MI_CNT))
#define EST ((int*)(ws + WS_MOEI + MI_EST))
#define TOPI ((int*)(ws + WS_MOEI + MI_TOPI))
#define TOPG ((float*)(ws + WS_MOEI + MI_TOPG))
#define RSTD ((float*)(ws + WS_MOEI + MI_RSTD))
#define POS ((int*)(ws + WS_MOEI + MI_POS))
#define RSTDG ((float*)(ws + WS_MOEI + MI_RSTDG))

    if (IN(0)) { PH_BEGIN phase_prologue(p, ws, lds, bid, G, gw, NGW, wave, lane, tid); SEAM(0); }
    if (IN(1)) { PH_BEGIN
        { pg8::Gemm g{MEMN, (const bf16*)(ws + WS_WCK), DM, DM, DM}; pg8::Order S; S.init(MROWS / 256, 4 * DM / 256, G, bid); S.plain(DM, DM);
          pg8::EpiBf16 E{KC, 4 * DM}; pg8::gemm_phase<pg8::EpiBf16, pg8::Order, true, true>(lds, g, S, E, wave); }
        { pg8::Gemm g{MEMN, (const bf16*)(ws + WS_WCV), DM, DM, DM}; pg8::Order S; S.init(MROWS / 256, 4 * DM / 256, G, bid); S.plain(DM, DM);
          pg8::EpiBf16 E{VT, 4 * DM}; pg8::gemm_phase<pg8::EpiBf16, pg8::Order, true, true>(lds, g, S, E, wave); }
        SEAM(1);
    }
    for (int l = 0; l < NL; ++l) {
        const int pb = 3 + 16 * l;
        if (IN(pb + 0)) { PH_BEGIN
            { pg8::Gemm g{(const bf16*)(ws + AR_Y), (const bf16*)(ws + WS_Q8IN + (size_t)l * INC * DM), DM / 2, DM / 2, DM / 2}; pg8::Order S; S.init(T / 256, INC / 256, G, bid); S.plain(DM / 2, DM / 2);
              pg8::EpiScaleI8 E{PROJ, INC, (const float*)(ws + WS_MOEI + MI_RSC0), (const float*)(ws + WS_Q8INS) + (size_t)l * INC}; pg8::gemm_phase<pg8::EpiScaleI8, pg8::Order, true, true, true>(lds, g, S, E, wave); }
            { const bool up = bid >= G / 2; const int hc = up ? bid - G / 2 : bid, hg = G / 2;
              if (up) { pg8::Gemm g{KC, (const bf16*)(ws + WS_WCQ), 256, 4 * DM, DM}; pg8::Order S; S.init(64, 4, hg, hc); S.mode = 1; S.lyr = l;
                  pg8::EpiBf16 E{(bf16*)(ws + WS_WK), DM}; pg8::gemm_phase<pg8::EpiBf16, pg8::Order, true, true>(lds, g, S, E, wave); }
              { pg8::Gemm g{(const bf16*)(ws + WS_WCO), VT, 256, DM, 4 * DM}; pg8::Order S; S.init(64, 4, hg, hc); S.mode = 2; S.lyr = l; if (up) S.uend = 128; else S.u0 = 128;
                  pg8::EpiBf16 E{(bf16*)(ws + WS_VO), DM}; pg8::gemm_phase<pg8::EpiBf16, pg8::Order, true, true>(lds, g, S, E, wave); } }
            SEAM(pb + 0);
        }
        if (IN(pb + 1)) { PH_BEGIN
            unsigned* ctr = (unsigned*)(ws + WS_CTL + 16384 + 256 * l); unsigned* ctrA = (unsigned*)(ws + WS_CTL + 24576 + 256 * l); float* SLOC = (float*)(ws + AR_XS);
            for (;;) {
                __syncthreads();
                if (tid == 0) *(LAS unsigned*)(lds + AT_UNIT) = __hip_atomic_fetch_add(ctr, 1u, __ATOMIC_RELAXED, __HIP_MEMORY_SCOPE_AGENT);
                __syncthreads();
                int u = __builtin_amdgcn_readfirstlane(*(LAS unsigned*)(lds + AT_UNIT));
                const bool conv_l = (l & 1) == 0;
                if (u >= 448 + 256 + 1024 + 512 + (conv_l ? CONV_PER : 0)) break;
                int lane_u = lane; asm volatile("" : "+v"(lane_u)); const int tid_u = wave * 64 + lane_u;
                if (conv_l && u >= 704) {
                    if (u < 704 + 1024 + CONV_PER) { const int j = u - 704, grp = j / 15, r = j - grp * 15;
                        if (r >= 4) { conv_unit(p, ws, lds, l >> 1, grp * 11 + (r - 4), wave, lane_u, tid_u); continue; }
                        u = 704 + grp * 4 + r; }
                    else u -= CONV_PER; }
                if (u < 448) ret_state_unit(PROJ, ROPE, SLOC, ctrA, u / 7, u % 7, lds, wave, lane_u, tid_u);
                else if (u < 704) s5_unit(p, l, PROJ, GB, u - 448, lds, wave, lane_u);
                else if (u < 1728) { const int v = u - 704; attn_unit<0>(PROJ, Y, ROPE, nullptr, nullptr, nullptr, v & 127, 7 - (v >> 7), lds, wave, lane_u, tid_u); }
                else { const int v = u - 1728; attn_unit<1>(PROJ, Y, ROPE, GIN(13) + l * DM + 256, SLOC, ctrA, v & 63, 7 - (v >> 6), lds, wave, lane_u, tid_u); }
            }
            SEAM(pb + 1);
        }
        if (IN(pb + 3)) { PH_BEGIN
            const float* gain = GIN(13) + l * DM;
            { pg8::Gemm g{GB, (const bf16*)(ws + WS_WGLU) + (size_t)l * 256 * 256, 256, 256, 256}; pg8::Order S; S.init(T / 256, 1, G, bid); S.plain(256, 256);
              pg8::EpiGlu E{GB, Y, DM, gain, (LAS float*)(lds + TAB_OFF)}; pg8::gemm_phase<pg8::EpiGlu, pg8::Order, true, true>(lds, g, S, E, wave); }
            for (int m = gw; m < T; m += NGW) {
                v4u* yp = (v4u*)(Y + (size_t)m * DM + 512) + lane; const v4u yv = *yp; float a[8]; unpack8(yv, a); float s = 0.f;
#pragma unroll
                for (int j = 0; j < 8; ++j) s += a[j] * a[j];
                const float rs = 1.0f / sqrtf(wave_sum(s) * (1.0f / 512.0f) + NORM_EPS); const f32x4 g0 = ((const f32x4*)(gain + 512))[2 * lane], g1 = ((const f32x4*)(gain + 512))[2 * lane + 1];
                v4u o; o.x = pk2(a[0] * rs * g0[0], a[1] * rs * g0[1]); o.y = pk2(a[2] * rs * g0[2], a[3] * rs * g0[3]); o.z = pk2(a[4] * rs * g1[0], a[5] * rs * g1[1]); o.w = pk2(a[6] * rs * g1[2], a[7] * rs * g1[3]); *yp = o; }
            SEAM(pb + 3);
        }
        if (IN(pb + 5)) { PH_BEGIN
            pg8::Gemm g{Y, (const bf16*)(ws + WS_WOUT) + (size_t)l * DM * DM, DM, DM, DM}; pg8::Order S; S.init(T / 256, DM / 256, G, bid); S.plain(DM, DM);
            pg8::EpiRes E{H, SSQ}; pg8::gemm_phase<pg8::EpiRes, pg8::Order, true, true>(lds, g, S, E, wave);
            SEAM(pb + 5);
        }
        if (IN(pb + 6)) { PH_BEGIN
            pg8::Gemm g{H, (const bf16*)(ws + WS_WK), DM, DM, DM}; pg8::Order S; S.init(T / 256, 4, G, bid);
            S.a_pm = 256L * DM * 2; S.b_pn = 256L * DM * 2; S.b_pb = (long)DM * DM * 2;
            pg8::EpiSoftmax E{PB, DM, (LAS float*)(lds + TAB_OFF), SSQ}; pg8::gemm_phase<pg8::EpiSoftmax, pg8::Order, true, true>(lds, g, S, E, wave);
            SEAM(pb + 6);
        }
        if (IN(pb + 7)) { PH_BEGIN
            pg8::Gemm g{PB, (const bf16*)(ws + WS_VO), DM, DM, DM}; pg8::Order S; S.init(T / 256, 4, G, bid);
            S.a_pm = 256L * DM * 2; S.b_pn = 256L * DM * 2; S.b_pb = (long)DM * DM * 2;
            pg8::EpiRes E{H, SSQ}; pg8::gemm_phase<pg8::EpiRes, pg8::Order, true, true>(lds, g, S, E, wave);
            SEAM(pb + 7);
        }
        if ((l & 1) == 0) {
            if (IN(pb + 8)) { PH_BEGIN
                unsigned char* HQ = (unsigned char*)(ws + AR_Y);
                for (int m = gw; m < T; m += NGW) { float a[8], b2[8]; unpack8(((const v4u*)(H + (size_t)m * DM))[lane], a); unpack8(((const v4u*)(H + (size_t)m * DM + 512))[lane], b2);
                    const float mx = absmax16(a, b2), step = mx > 0.f ? mx * (1.0f / 127.0f) : 1.0f, inv = 1.0f / step;
                    ((v2u*)(HQ + (size_t)m * DM))[lane] = q8_pack8(a, inv); ((v2u*)(HQ + (size_t)m * DM + 512))[lane] = q8_pack8(b2, inv);
                    if (lane == 0) RSTD[m] = step * rstd16(SSQ, m); }
                SEAM(pb + 8);
            }
            if (IN(pb + 11)) { PH_BEGIN
                pg8::Gemm g{(const bf16*)(ws + AR_Y), (const bf16*)(ws + WS_Q8W + (size_t)(l >> 1) * 2 * FF * DM), DM / 2, DM / 2, DM / 2}; pg8::Order S; S.init(T / 256, 2 * FF / 256, G, bid); S.plain(DM / 2, DM / 2);
                pg8::EpiSwigluI8 E{ACT, FF, RSTD, (const float*)(ws + WS_Q8S) + (size_t)(l >> 1) * 2 * FF, 0}; pg8::gemm_phase<pg8::EpiSwigluI8, pg8::Order, true, true, true>(lds, g, S, E, wave);
                SEAM(pb + 11);
            }
            if (IN(pb + 12)) { PH_BEGIN
                pg8::Gemm g{ACT, (const bf16*)(ws + WS_WDDN) + (size_t)(l >> 1) * DM * FF, FF, FF, FF}; pg8::Order S; S.init(T / 256, DM / 256, G, bid); S.plain(FF, FF);
                pg8::EpiRes E{H, SSQ}; pg8::gemm_phase<pg8::EpiRes, pg8::Order, true, true>(lds, g, S, E, wave);
                SEAM(pb + 12);
            }
            if (IN(pb + 13)) { PH_BEGIN
                unsigned char* HQ = (unsigned char*)(ws + AR_Y); float* RSC0 = (float*)(ws + WS_MOEI + MI_RSC0);
                for (int m = gw; m < T; m += NGW) { float a[8], b2[8]; unpack8(((const v4u*)(H + (size_t)m * DM))[lane], a); unpack8(((const v4u*)(H + (size_t)m * DM + 512))[lane], b2);
                    const float mx = absmax16(a, b2), step = mx > 0.f ? mx * (1.0f / 127.0f) : 1.0f, inv = 1.0f / step;
                    ((v2u*)(HQ + (size_t)m * DM))[lane] = q8_pack8(a, inv); ((v2u*)(HQ + (size_t)m * DM + 512))[lane] = q8_pack8(b2, inv);
                    if (lane == 0) RSC0[m] = step * rstd16(SSQ, m); }
                SEAM(pb + 13);
            }
        } else {
            if (IN(pb + 11)) { PH_BEGIN
                LAS int* hist = (LAS int*)lds; LAS float* lgs = (LAS float*)(lds + 64) + wave * 128; if (tid < 8) hist[tid] = 0; __syncthreads();
                const float* WRl = (const float*)(ws + WS_WR) + (size_t)(l >> 1) * DM * NEXP;
                const int tok0 = bid * 128 + wave * 16, lr = lane & 15, lq = lane >> 4;
                f32x4 acc = {0.f, 0.f, 0.f, 0.f};
                const bf16* hp = H + (size_t)(tok0 + lr) * DM + 8 * lq; const float* wp = WRl + (size_t)(8 * lq) * 8 + (lr & 7); const float bm = lr < 8 ? 1.0f : 0.0f;
#pragma unroll 2
                for (int s2 = 0; s2 < 32; ++s2) { float a[8]; unpack8(*(const v4u*)(hp + 32 * s2), a);
#pragma unroll
                    for (int j = 0; j < 8; ++j) acc = __builtin_amdgcn_mfma_f32_16x16x4f32(a[j], wp[(size_t)(32 * s2 + j) * 8] * bm, acc, 0, 0, 0); }
                if (lr < 8) {
#pragma unroll
                    for (int rg = 0; rg < 4; ++rg) lgs[(4 * lq + rg) * 8 + lr] = acc[rg]; }
                asm volatile("s_waitcnt lgkmcnt(0)" ::: "memory");
                if (lane < 16) { const int row = tok0 + lane; const float rs = rstd16(SSQ, row); const f32x4 l0 = *(const LAS f32x4*)(lgs + lane * 8), l1 = *(const LAS f32x4*)(lgs + lane * 8 + 4);
                    const float lg[8] = {l0[0] * rs, l0[1] * rs, l0[2] * rs, l0[3] * rs, l1[0] * rs, l1[1] * rs, l1[2] * rs, l1[3] * rs};
                    float v1 = lg[0]; int i1 = 0;
#pragma unroll
                    for (int e = 1; e < 8; ++e) if (lg[e] > v1) { v1 = lg[e]; i1 = e; }
                    float v2 = -3.0e38f; int i2 = -1;
#pragma unroll
                    for (int e = 0; e < 8; ++e) if (e != i1 && lg[e] > v2) { v2 = lg[e]; i2 = e; }
                    const float g2 = 1.0f / (1.0f + expf(v1 - v2)), g1 = 1.0f - g2;
                    TOPI[2 * row] = i1; TOPI[2 * row + 1] = i2; TOPG[2 * row] = g1; TOPG[2 * row + 1] = g2; RSTD[row] = rs;
                    __hip_atomic_fetch_add(&hist[i1], 1, __ATOMIC_RELAXED, __HIP_MEMORY_SCOPE_WORKGROUP); __hip_atomic_fetch_add(&hist[i2], 1, __ATOMIC_RELAXED, __HIP_MEMORY_SCOPE_WORKGROUP); }
                __syncthreads(); if (tid < 8) CNT[bid * 8 + tid] = hist[tid];
                SEAM(pb + 11);
            }
            if (IN(pb + 12)) { PH_BEGIN
                unsigned char* XQ = (unsigned char*)(ws + AR_XG);
                LAS int* sh = (LAS int*)lds;
                if (tid < 16) sh[tid] = 0;
                __syncthreads();
                { const int4 c = ((const int4*)CNT)[tid]; const int w = tid >> 1, e0 = 4 * (tid & 1); const int cc[4] = {c.x, c.y, c.z, c.w};
#pragma unroll
                  for (int i = 0; i < 4; ++i) { __hip_atomic_fetch_add(&sh[e0 + i], cc[i], __ATOMIC_RELAXED, __HIP_MEMORY_SCOPE_WORKGROUP); if (w < bid) __hip_atomic_fetch_add(&sh[8 + e0 + i], cc[i], __ATOMIC_RELAXED, __HIP_MEMORY_SCOPE_WORKGROUP); } }
                int myexp = 0; if (tid < 256) { myexp = TOPI[(size_t)bid * 256 + tid]; sh[320 + tid] = myexp; }
                __syncthreads();
                if (tid == 0) { int s = 0; for (int e = 0; e < 8; ++e) { sh[16 + e] = s; sh[32 + e] = s + sh[8 + e]; s += (sh[e] + 255) & ~255; } sh[24] = s;
                    if (bid == 0) for (int e = 0; e < 9; ++e) EST[e] = sh[16 + e]; }
                int rank = 0;
                if (tid < 256) {
#pragma unroll
                    for (int e = 0; e < 8; ++e) { const unsigned long long m = __builtin_amdgcn_ballot_w64(myexp == e); if (myexp == e) rank = __builtin_popcountll(m & ((1ull << lane) - 1ull)); if (lane == 0) sh[576 + wave * 8 + e] = __builtin_popcountll(m); } }
                __syncthreads();
                if (tid < 256) { int pos = sh[32 + myexp] + rank; for (int w2 = 0; w2 < wave; ++w2) pos += sh[576 + w2 * 8 + myexp]; sh[64 + tid] = pos; }
                __syncthreads();
#pragma unroll 1
                for (int k4 = 0; k4 < 4; ++k4) { v4u a[4], b2[4]; float rs[4];
#pragma unroll
                    for (int q = 0; q < 4; ++q) { const int row = bid * 128 + wave * 16 + 4 * k4 + q; a[q] = ((const v4u*)(H + (size_t)row * DM))[lane]; b2[q] = ((const v4u*)(H + (size_t)row * DM + 512))[lane]; rs[q] = RSTD[row]; }
#pragma unroll
                    for (int q = 0; q < 4; ++q) { const int k = wave * 16 + 4 * k4 + q, row = bid * 128 + k;
                        float fa[8], fb[8]; unpack8(a[q], fa); unpack8(b2[q], fb);
                        const float mx = absmax16(fa, fb), step = mx > 0.f ? mx * (1.0f / 127.0f) : 1.0f, inv = 1.0f / step; const v2u qa = q8_pack8(fa, inv), qb = q8_pack8(fb, inv);
#pragma unroll
                        for (int sl = 0; sl < 2; ++sl) { const int pos = sh[64 + 2 * k + sl]; ((v2u*)(XQ + (size_t)pos * DM))[lane] = qa; ((v2u*)(XQ + (size_t)pos * DM + 512))[lane] = qb;
                            if (lane == 0) { RSTDG[pos] = rs[q] * step; POS[2 * row + sl] = pos; } } } }
                { const int e = bid & 7, i = (bid >> 3) * 8 + wave, pos = sh[16 + e] + sh[e] + i;
                  if (pos < sh[16 + e + 1]) { unsigned zz = 0u; asm volatile("" : "+v"(zz)); const v4u z = {zz, zz, zz, zz}; ((v4u*)(XQ + (size_t)pos * DM))[lane] = z; if (lane == 0) RSTDG[pos] = 0.f; } }
                SEAM(pb + 12);
            }
            if (IN(pb + 13)) { PH_BEGIN
                const int nM = __builtin_amdgcn_readfirstlane(EST[8]) / 256;
                pg8::Gemm g{(const bf16*)(ws + AR_XG), (const bf16*)(ws + WS_Q8W + (size_t)(2 + (l >> 1) * NEXP) * 2 * FF * DM), DM / 2, DM / 2, DM / 2}; pg8::Order S; S.init(nM, 2 * FF / 256, G, bid); S.plain(DM / 2, DM / 2);
                S.estart = EST; S.b_e = (long)2 * FF * DM;
                pg8::EpiSwigluI8 E{ACTG, FF, RSTDG, (const float*)(ws + WS_Q8S) + (size_t)(2 + (l >> 1) * NEXP) * 2 * FF, 2 * FF}; pg8::gemm_phase<pg8::EpiSwigluI8, pg8::Order, true, true, true>(lds, g, S, E, wave);
                SEAM(pb + 13);
            }
            if (IN(pb + 14)) { PH_BEGIN
                const int nM = __builtin_amdgcn_readfirstlane(EST[8]) / 256, nMain = nM < 256 ? nM : 256, nOv = nM - nMain;
                { pg8::Gemm g{ACTG, (const bf16*)(ws + WS_WEDN) + (size_t)(l >> 1) * NEXP * DM * FF, FF, FF, FF}; pg8::Order S; S.init(nMain, DM / 256, G, bid); S.plain(FF, FF);
                  S.estart = EST; S.b_e = (long)DM * FF * 2;
                  pg8::EpiBf16 E{DG, DM}; pg8::gemm_phase<pg8::EpiBf16, pg8::Order, true, true>(lds, g, S, E, wave); }
                if (nOv > 0) { pg8::Gemm g{ACTG, (const bf16*)(ws + WS_WEDN) + (size_t)(l >> 1) * NEXP * DM * FF, 256, FF, FF}; pg8::Order S; S.init(nOv * 11, DM / 256, G, bid); S.mode = 3; S.estart = EST;
                  pg8::EpiF32 E{(float*)(ws + AR_XG), DM}; pg8::gemm_phase<pg8::EpiF32, pg8::Order, true, true>(lds, g, S, E, wave); }
                SEAM(pb + 14);
            }
            if (IN(pb + 15)) { PH_BEGIN
                const bool last = (l == NL - 1); const float* fw = GIN(26); float* outp = ((float*)(GAS float*)p->out);
                for (int m = gw; m < T; m += NGW) { const int p0 = POS[2 * m], p1 = POS[2 * m + 1]; const float g0 = TOPG[2 * m], g1 = TOPG[2 * m + 1]; float s = 0.f; float hv[2][8];
#pragma unroll
                    for (int hf = 0; hf < 2; ++hf) { v4u* hp = (v4u*)(H + (size_t)m * DM + 512 * hf) + lane; float a[8], d0[8], d1[8]; unpack8(*hp, a);
                        auto ldrow = [&](int pp, float* d) { if (pp < 65536) { unpack8(((const v4u*)(DG + (size_t)pp * DM + 512 * hf))[lane], d); }
                            else { const int ov = pp - 65536, pmo = ov >> 8, rr = ov & 255; const float* base = (const float*)(ws + AR_XG) + ((size_t)(pmo * 11) * 256 + rr) * DM + 512 * hf + 8 * lane;
#pragma unroll
                                for (int j = 0; j < 8; ++j) d[j] = 0.f;
                                for (int ks = 0; ks < 11; ++ks) { const f32x4 q0 = *(const f32x4*)(base + (size_t)ks * 256 * DM), q1 = *(const f32x4*)(base + (size_t)ks * 256 * DM + 4);
#pragma unroll
                                    for (int j = 0; j < 4; ++j) { d[j] += q0[j]; d[4 + j] += q1[j]; } } } };
                        ldrow(p0, d0); ldrow(p1, d1);
#pragma unroll
                        for (int j = 0; j < 8; ++j) a[j] += g0 * d0[j] + g1 * d1[j];
                        v4u o; o.x = pk2(a[0], a[1]); o.y = pk2(a[2], a[3]); o.z = pk2(a[4], a[5]); o.w = pk2(a[6], a[7]); if (!last) *hp = o;
                        unpack8(o, hv[hf]);
#pragma unroll
                        for (int j = 0; j < 8; ++j) s += hv[hf][j] * hv[hf][j]; }
                    s = wave_sum(s);
                    if (!last) { if (lane < 16) SSQ[(size_t)m * 16 + lane] = lane == 0 ? s : 0.f;
                        float mx = 0.f;
#pragma unroll
                        for (int hf = 0; hf < 2; ++hf)
#pragma unroll
                            for (int j = 0; j < 8; ++j) mx = fmaxf(mx, fabsf(hv[hf][j]));
                        mx = wave_max(mx); const float step = mx > 0.f ? mx * (1.0f / 127.0f) : 1.0f, inv = 1.0f / step;
                        ((v2u*)((unsigned char*)(ws + AR_Y) + (size_t)m * DM))[lane] = q8_pack8(hv[0], inv); ((v2u*)((unsigned char*)(ws + AR_Y) + (size_t)m * DM + 512))[lane] = q8_pack8(hv[1], inv);
                        if (lane == 0) ((float*)(ws + WS_MOEI + MI_RSC0))[m] = step / sqrtf(s * (1.0f / DM) + NORM_EPS); }
                    else { const float rs = 1.0f / sqrtf(s * (1.0f / DM) + NORM_EPS);
#pragma unroll
                        for (int hf = 0; hf < 2; ++hf) { const f32x4 w0 = ((const f32x4*)(fw + 512 * hf))[2 * lane], w1 = ((const f32x4*)(fw + 512 * hf))[2 * lane + 1];
                            f32x4 o0 = {hv[hf][0] * rs * w0[0], hv[hf][1] * rs * w0[1], hv[hf][2] * rs * w0[2], hv[hf][3] * rs * w0[3]}, o1 = {hv[hf][4] * rs * w1[0], hv[hf][5] * rs * w1[1], hv[hf][6] * rs * w1[2], hv[hf][7] * rs * w1[3]};
                            f32x4* op = (f32x4*)(outp + (size_t)m * DM + 512 * hf) + 2 * lane; op[0] = o0; op[1] = o1; } } }
                SEAM(pb + 15);
            }
        }
    }
#undef IN
#undef SEAM
}

extern "C" void kernel_launch(void* const* d_in, const int* in_sizes, int n_in, void* d_out, int out_size, void* d_ws, size_t ws_size, hipStream_t stream) {
    static int grid = 0;
    if (grid == 0) {
        if (n_in != 27 || in_sizes[0] != T * DM || out_size != T * DM || ws_size < WS_END) { fprintf(stderr, "kernel_launch: unexpected problem (n_in %d, in0 %d, out %d, ws %zu < %zu); nothing launched\n", n_in, n_in > 0 ? in_sizes[0] : -1, out_size, ws_size, (size_t)WS_END); grid = -1; return; }
        int dev = 0, cus = 0;
        if (hipGetDevice(&dev) != hipSuccess || hipDeviceGetAttribute(&cus, hipDeviceAttributeMultiprocessorCount, dev) != hipSuccess) { fprintf(stderr, "kernel_launch: device query failed\n"); grid = -1; return; }
        if (hipFuncSetAttribute((const void*)mk_fwd, hipFuncAttributeMaxDynamicSharedMemorySize, LDS_BYTES) != hipSuccess) { fprintf(stderr, "kernel_launch: hipFuncSetAttribute failed\n"); grid = -1; return; }
        int per_cu = 0; (void)hipOccupancyMaxActiveBlocksPerMultiprocessor(&per_cu, (const void*)mk_fwd, 512, LDS_BYTES); (void)hipGetLastError();
        if (cus != 256 || per_cu < 1) { fprintf(stderr, "kernel_launch: needs 256 CUs with one resident workgroup each (cus %d, per_cu %d)\n", cus, per_cu); grid = -1; return; }
        grid = 256;
    }
    if (grid < 0) return;
    (void)hipMemsetAsync((char*)d_ws + WS_CTL, 0, 32768, stream);
    P a{};
    for (int i = 0; i < 27; ++i) a.in[i] = (const float*)d_in[i];
    a.out = (float*)d_out; a.ws = (unsigned char*)d_ws;
    constexpr int NPH = 3 + 16 * NL;
#if MK_MULTI
    for (int ph = 0; ph < NPH; ++ph) {
        if (ph >= 3 && ph < 3 + 16 * NL) { const int l = (ph - 3) / 16, k = (ph - 3) % 16; if ((l & 1) == 0 && k > 13) continue; }
        a.ph_lo = ph; a.ph_hi = ph + 1;
        hipLaunchKernelGGL(mk_fwd, dim3(grid), dim3(512), LDS_BYTES, stream, a);
    }
#else
    a.ph_lo = 0; a.ph_hi = NPH;
    hipLaunchKernelGGL(mk_fwd, dim3(grid), dim3(512), LDS_BYTES, stream, a);
#endif
}
```

```cpp
#include <hip/hip_runtime.h>
#include <cstdio>
#include <cstdint>
#ifndef MK_MULTI
#define MK_MULTI 0
#endif
namespace pg8 {
#define PG8_LAS __attribute__((address_space(3)))
typedef unsigned short bf16_t;
typedef short bf16x8 __attribute__((ext_vector_type(8)));
typedef float f32x4 __attribute__((ext_vector_type(4)));
typedef unsigned u32x4 __attribute__((ext_vector_type(4)));
typedef int i32x4 __attribute__((ext_vector_type(4)));
template <bool I8> struct AccSel { typedef f32x4 T; };
template <> struct AccSel<true> { typedef i32x4 T; };
template <bool I8> __device__ __forceinline__ typename AccSel<I8>::T mma1(bf16x8 b, bf16x8 a, typename AccSel<I8>::T c) {
    if constexpr (I8) return __builtin_amdgcn_mfma_i32_16x16x64_i8(__builtin_bit_cast(i32x4, b), __builtin_bit_cast(i32x4, a), c, 0, 0, 0);
    else return __builtin_amdgcn_mfma_f32_16x16x32_bf16(b, a, c, 0, 0, 0);
}
constexpr int BM = 256, BK = 64, HALF = 128, HTB = HALF * BK * 2  , STAGE_BYTES = 8 * HTB, NXCD = 8, WGM = 8;

__host__ __device__ __forceinline__ int lds_byte(int r, int c) { const int st = (r >> 4) * 2 + (c >> 5), rr = r & 15, cc = c & 31, ob = rr * 64 + cc * 2; return st * 1024 + (ob ^ (((ob >> 9) & 1) << 5)); }
__host__ __device__ __forceinline__ void stage_rc(int b, int& R, int& C) { const int st = b / 1024, sb = b % 1024, swz = sb ^ (((sb >> 9) & 1) << 5); R = (st >> 1) * 16 + swz / 64; C = (st & 1) * 32 + (swz % 64) / 2; }
__host__ __device__ __forceinline__ int perm32(int rho) { const int n = rho >> 4, i = rho & 15; return 8 * (i >> 2) + 4 * n + (i & 3); }

struct Unit { int pm, pn; long aoff, boff; int e; int par; };
struct Gemm { const bf16_t* A; const bf16_t* Bt; int K, lda, ldb; };

struct Order {
    int nM, nN, nwg, G, c, mode, lyr, u0, uend; long a_pm, a_pn, b0, b_pn, b_pb, b_e; const int* estart;
    __device__ void init(int nM_, int nN_, int G_, int c_) { nM = nM_; nN = nN_; nwg = nM * nN; G = G_; c = c_; u0 = 0; uend = nwg; mode = 0; lyr = 0; a_pm = 0; a_pn = 0; b0 = 0; b_pn = 0; b_pb = 0; b_e = 0; estart = nullptr; }
    __device__ void plain(int lda, int ldb) { a_pm = 256L * lda * 2; b_pn = 256L * ldb * 2; }
    __device__ bool next(int i, Unit& u) const {
        const long L = (long)u0 + (long)i * G + c; if (L >= uend) return false;
        int wgid = (int)L; { const int q = nwg / NXCD, r = nwg % NXCD, xcd = wgid % NXCD, off = wgid / NXCD; wgid = (xcd < r ? xcd * (q + 1) : r * (q + 1) + (xcd - r) * q) + off; }
        const int nig = WGM * nN, gid = wgid / nig, fm = gid * WGM, gsz = (nM - fm) < WGM ? (nM - fm) : WGM;
        u.pm = fm + ((wgid % nig) % gsz); u.pn = (wgid % nig) / gsz;
        long e = 0; if (estart && mode == 0) { const int r0 = u.pm * 256;
#pragma unroll
            for (int j = 1; j < 8; ++j) e += (r0 >= __builtin_amdgcn_readfirstlane(estart[j])) ? 1 : 0; }
        if (mode == 1)      { const long l = lyr, b = (u.pm >> 2) & 15, hh = u.pm & 3; u.aoff = ((b * 256) * 4096 + l * 1024 + hh * 256) * 2; u.boff = ((l * 1024 + u.pn * 256) * 1024 + hh * 256) * 2; }
        else if (mode == 2) { const long l = lyr, b = (u.pm >> 2) & 15, nt = u.pm & 3; u.aoff = ((l * 1024 + nt * 256) * 1024 + u.pn * 256) * 2; u.boff = ((b * 256) * 4096 + l * 1024 + u.pn * 256) * 2; }
        else if (mode == 3) { const int pmo = u.pm / 11, ks = u.pm - pmo * 11; const int r0 = (256 + pmo) * 256; long e3 = 0;
#pragma unroll
            for (int j = 1; j < 8; ++j) e3 += (r0 >= __builtin_amdgcn_readfirstlane(estart[j])) ? 1 : 0;
            u.aoff = ((long)r0 * 2816 + ks * 256) * 2; u.boff = ((e3 * 1024 + u.pn * 256) * 2816 + ks * 256) * 2; }
        else { u.aoff = u.pm * a_pm + u.pn * a_pn; u.boff = b0 + u.pn * b_pn + (long)(u.pm >> 3) * b_pb + e * b_e; }
        u.e = (int)e; return true;
    }
    __device__ __forceinline__ void a_ready(const Unit&) const {}
    __device__ __forceinline__ void done(const Unit&) const {}
};

__device__ __forceinline__ unsigned cvt_pk_bf16(float lo, float hi) { unsigned r; asm volatile("v_cvt_pk_bf16_f32 %0, %1, %2" : "=v"(r) : "v"(lo), "v"(hi)); return r; }
__device__ __forceinline__ float bflo(unsigned w) { return __uint_as_float(w << 16); }
__device__ __forceinline__ float bfhi(unsigned w) { return __uint_as_float(w & 0xffff0000u); }
__device__ __forceinline__ float rstd16(const float* ssq, int r) {
    const f32x4* p = (const f32x4*)(ssq + (size_t)r * 16); const f32x4 a = p[0], b = p[1], c = p[2], d = p[3];
    const float s = (((a[0] + a[1]) + (a[2] + a[3])) + ((b[0] + b[1]) + (b[2] + b[3]))) + (((c[0] + c[1]) + (c[2] + c[3])) + ((d[0] + d[1]) + (d[2] + d[3])));
    return __builtin_amdgcn_rsqf(s * (1.0f / 1024.0f) + 1e-6f);
}

template <class E> struct EpiPre { static constexpr bool v = false; };
struct EpiF32 {
    static constexpr bool PERM = true, AFTER_DRAIN = false;
    float* C; int ldc;
    __device__ __forceinline__ void operator()(const f32x4 (&acc)[2][2][4][2], const Unit& u, int wr, int wc, int fr, int fq) const {
        const int row0 = u.pm * BM + wr * 64 + fr, col0 = u.pn * BM + wc * 32 + 8 * fq;
#pragma unroll
        for (int ai = 0; ai < 2; ++ai)
#pragma unroll
            for (int m = 0; m < 4; ++m) { float* rowp = C + (size_t)(row0 + ai * HALF + m * 16) * ldc + col0;
#pragma unroll
                for (int bj = 0; bj < 2; ++bj) { *(f32x4*)(rowp + bj * HALF) = acc[ai][bj][m][0]; *(f32x4*)(rowp + bj * HALF + 4) = acc[ai][bj][m][1]; } }
    }
};
struct EpiBf16 {
    static constexpr bool PERM = true, AFTER_DRAIN = false;
    bf16_t* O; int ldc;
    __device__ __forceinline__ void operator()(const f32x4 (&acc)[2][2][4][2], const Unit& u, int wr, int wc, int fr, int fq) const {
        const int row0 = u.pm * BM + wr * 64 + fr, col0 = u.pn * BM + wc * 32 + 8 * fq;
#pragma unroll
        for (int ai = 0; ai < 2; ++ai)
#pragma unroll
            for (int m = 0; m < 4; ++m) { bf16_t* rowp = O + (size_t)(row0 + ai * HALF + m * 16) * ldc + col0;
#pragma unroll
                for (int bj = 0; bj < 2; ++bj) { const f32x4 v0 = acc[ai][bj][m][0], v1 = acc[ai][bj][m][1];
                    u32x4 w; w.x = cvt_pk_bf16(v0[0], v0[1]); w.y = cvt_pk_bf16(v0[2], v0[3]); w.z = cvt_pk_bf16(v1[0], v1[1]); w.w = cvt_pk_bf16(v1[2], v1[3]);
                    *(u32x4*)(rowp + bj * HALF) = w; } }
    }
};
struct EpiScale {
    static constexpr bool PERM = true, AFTER_DRAIN = false;
    bf16_t* O; int ldc; const float* ssq;
    __device__ __forceinline__ void operator()(const f32x4 (&acc)[2][2][4][2], const Unit& u, int wr, int wc, int fr, int fq) const {
        const int row0 = u.pm * BM + wr * 64 + fr, col0 = u.pn * BM + wc * 32 + 8 * fq;
#pragma unroll
        for (int ai = 0; ai < 2; ++ai)
#pragma unroll
            for (int m = 0; m < 4; ++m) { const int r = row0 + ai * HALF + m * 16; const float rs = rstd16(ssq, r); bf16_t* rowp = O + (size_t)r * ldc + col0;
#pragma unroll
                for (int bj = 0; bj < 2; ++bj) { const f32x4 v0 = acc[ai][bj][m][0] * rs, v1 = acc[ai][bj][m][1] * rs;
                    u32x4 w; w.x = cvt_pk_bf16(v0[0], v0[1]); w.y = cvt_pk_bf16(v0[2], v0[3]); w.z = cvt_pk_bf16(v1[0], v1[1]); w.w = cvt_pk_bf16(v1[2], v1[3]);
                    *(u32x4*)(rowp + bj * HALF) = w; } }
    }
};
struct EpiRes {
    static constexpr bool PERM = true, AFTER_DRAIN = false;
    bf16_t* H; float* ssq;
    __device__ __forceinline__ void operator()(const f32x4 (&acc)[2][2][4][2], const Unit& u, int wr, int wc, int fr, int fq) const {
        const int row0 = u.pm * BM + wr * 64 + fr, col0 = u.pn * BM + wc * 32 + 8 * fq;
#pragma unroll
        for (int ai = 0; ai < 2; ++ai)
#pragma unroll
            for (int m = 0; m < 4; ++m) { const int r = row0 + ai * HALF + m * 16; bf16_t* rowp = H + (size_t)r * 1024 + col0; float s = 0.f;
#pragma unroll
                for (int bj = 0; bj < 2; ++bj) { const u32x4 o = *(const u32x4*)(rowp + bj * HALF); const f32x4 a0 = acc[ai][bj][m][0], a1 = acc[ai][bj][m][1];
                    u32x4 w; w.x = cvt_pk_bf16(a0[0] + bflo(o.x), a0[1] + bfhi(o.x)); w.y = cvt_pk_bf16(a0[2] + bflo(o.y), a0[3] + bfhi(o.y));
                    w.z = cvt_pk_bf16(a1[0] + bflo(o.z), a1[1] + bfhi(o.z)); w.w = cvt_pk_bf16(a1[2] + bflo(o.w), a1[3] + bfhi(o.w));
                    *(u32x4*)(rowp + bj * HALF) = w;
                    s += (bflo(w.x) * bflo(w.x) + bfhi(w.x) * bfhi(w.x)) + (bflo(w.y) * bflo(w.y) + bfhi(w.y) * bfhi(w.y)) + (bflo(w.z) * bflo(w.z) + bfhi(w.z) * bfhi(w.z)) + (bflo(w.w) * bflo(w.w) + bfhi(w.w) * bfhi(w.w)); }
                s += __shfl_xor(s, 16); s += __shfl_xor(s, 32);
                if (fq == 0) ssq[(size_t)r * 16 + u.pn * 4 + wc] = s; }
    }
};
struct EpiSoftmax {
    static constexpr bool PERM = true, AFTER_DRAIN = false;
    bf16_t* O; int ldc; PG8_LAS float* tab; const float* ssq;
    __device__ __forceinline__ void operator()(f32x4 (&acc)[2][2][4][2], const Unit& u, int wr, int wc, int fr, int fq) const {
        const int row0 = u.pm * BM + wr * 64 + fr, col0 = u.pn * BM + wc * 32 + 8 * fq;
#pragma unroll
        for (int ai = 0; ai < 2; ++ai)
#pragma unroll
            for (int m = 0; m < 4; ++m) { float mx = -3.0e38f; const float rs = ssq ? rstd16(ssq, row0 + ai * HALF + m * 16) : 1.0f;
#pragma unroll
                for (int bj = 0; bj < 2; ++bj)
#pragma unroll
                    for (int n = 0; n < 2; ++n) { const f32x4 x = acc[ai][bj][m][n] * rs; acc[ai][bj][m][n] = x; mx = fmaxf(mx, fmaxf(fmaxf(x[0], x[1]), fmaxf(x[2], x[3]))); }
                mx = fmaxf(mx, __shfl_xor(mx, 16)); mx = fmaxf(mx, __shfl_xor(mx, 32));
                if (fq == 0) tab[(ai * HALF + wr * 64 + m * 16 + fr) * 4 + wc] = mx; }
        asm volatile("s_waitcnt lgkmcnt(0)" ::: "memory"); __builtin_amdgcn_s_barrier(); asm volatile("" ::: "memory");
#pragma unroll
        for (int ai = 0; ai < 2; ++ai)
#pragma unroll
            for (int m = 0; m < 4; ++m) { const int rl = ai * HALF + wr * 64 + m * 16 + fr; const f32x4 t = *(const PG8_LAS f32x4*)(tab + rl * 4); const float M = fmaxf(fmaxf(t[0], t[1]), fmaxf(t[2], t[3])); float s = 0.f;
#pragma unroll
                for (int bj = 0; bj < 2; ++bj)
#pragma unroll
                    for (int n = 0; n < 2; ++n) { f32x4 e;
#pragma unroll
                        for (int j = 0; j < 4; ++j) e[j] = __builtin_amdgcn_exp2f(acc[ai][bj][m][n][j] - M);
                        acc[ai][bj][m][n] = e; s += (e[0] + e[1]) + (e[2] + e[3]); }
                s += __shfl_xor(s, 16); s += __shfl_xor(s, 32);
                if (fq == 0) tab[1024 + rl * 4 + wc] = s; }
        asm volatile("s_waitcnt lgkmcnt(0)" ::: "memory"); __builtin_amdgcn_s_barrier(); asm volatile("" ::: "memory");
#pragma unroll
        for (int ai = 0; ai < 2; ++ai)
#pragma unroll
            for (int m = 0; m < 4; ++m) { const int rl = ai * HALF + wr * 64 + m * 16 + fr; const f32x4 t = *(const PG8_LAS f32x4*)(tab + 1024 + rl * 4); const float inv = 1.0f / ((t[0] + t[1]) + (t[2] + t[3]));
                bf16_t* rowp = O + (size_t)(row0 + ai * HALF + m * 16) * ldc + col0;
#pragma unroll
                for (int bj = 0; bj < 2; ++bj) { const f32x4 v0 = acc[ai][bj][m][0] * inv, v1 = acc[ai][bj][m][1] * inv;
                    u32x4 w; w.x = cvt_pk_bf16(v0[0], v0[1]); w.y = cvt_pk_bf16(v0[2], v0[3]); w.z = cvt_pk_bf16(v1[0], v1[1]); w.w = cvt_pk_bf16(v1[2], v1[3]);
                    *(u32x4*)(rowp + bj * HALF) = w; } }
    }
};
struct EpiGlu {
    static constexpr bool PERM = true, AFTER_DRAIN = false;
    const bf16_t* G; bf16_t* O; int ldc; const float* gain; PG8_LAS float* tab;
    __device__ __forceinline__ void operator()(f32x4 (&acc)[2][2][4][2], const Unit& u, int wr, int wc, int fr, int fq) const {
        const int row0 = u.pm * BM + wr * 64 + fr, col0 = wc * 32 + 8 * fq;
#pragma unroll
        for (int ai = 0; ai < 2; ++ai)
#pragma unroll
            for (int m = 0; m < 4; ++m) { const int r = row0 + ai * HALF + m * 16; float s = 0.f;
#pragma unroll
                for (int bj = 0; bj < 2; ++bj) { const u32x4 gv = *(const u32x4*)(G + (size_t)r * 256 + col0 + bj * HALF);
                    const float gg[8] = {bflo(gv.x), bfhi(gv.x), bflo(gv.y), bfhi(gv.y), bflo(gv.z), bfhi(gv.z), bflo(gv.w), bfhi(gv.w)};
#pragma unroll
                    for (int n = 0; n < 2; ++n) { f32x4 a;
#pragma unroll
                        for (int j = 0; j < 4; ++j) { a[j] = gg[4 * n + j] * __builtin_amdgcn_rcpf(1.0f + __expf(-acc[ai][bj][m][n][j])); s += a[j] * a[j]; }
                        acc[ai][bj][m][n] = a; } }
                s += __shfl_xor(s, 16); s += __shfl_xor(s, 32);
                if (fq == 0) tab[(ai * HALF + wr * 64 + m * 16 + fr) * 4 + wc] = s; }
        asm volatile("s_waitcnt lgkmcnt(0)" ::: "memory"); __builtin_amdgcn_s_barrier(); asm volatile("" ::: "memory");
#pragma unroll
        for (int ai = 0; ai < 2; ++ai)
#pragma unroll
            for (int m = 0; m < 4; ++m) { const int rl = ai * HALF + wr * 64 + m * 16 + fr; const f32x4 t = *(const PG8_LAS f32x4*)(tab + rl * 4); const float rs = 1.0f / sqrtf(((t[0] + t[1]) + (t[2] + t[3])) * (1.0f / 256.0f) + 1e-6f);
                bf16_t* rowp = O + (size_t)(row0 + ai * HALF + m * 16) * ldc + col0;
#pragma unroll
                for (int bj = 0; bj < 2; ++bj) { const f32x4 g0 = *(const f32x4*)(gain + col0 + bj * HALF), g1 = *(const f32x4*)(gain + col0 + bj * HALF + 4);
                    const f32x4 v0 = acc[ai][bj][m][0] * rs * g0, v1 = acc[ai][bj][m][1] * rs * g1;
                    u32x4 w; w.x = cvt_pk_bf16(v0[0], v0[1]); w.y = cvt_pk_bf16(v0[2], v0[3]); w.z = cvt_pk_bf16(v1[0], v1[1]); w.w = cvt_pk_bf16(v1[2], v1[3]);
                    *(u32x4*)(rowp + bj * HALF) = w; } }
    }
};
struct EpiScaleI8 {
    static constexpr bool PERM = true, AFTER_DRAIN = false;
    bf16_t* O; int ldc; const float* rsd; const float* wsc; PG8_LAS float* tab;
    __device__ __forceinline__ void pre(const Unit& u, int tid, int wid) const { const float* src = tid < 256 ? rsd + u.pm * BM + tid : wsc + u.pn * BM + (tid - 256);
        __builtin_amdgcn_global_load_lds((const unsigned*)src, (PG8_LAS unsigned*)(tab + u.par * 512 + wid * 64), 4, 0, 0); }
    __device__ __forceinline__ void operator()(const i32x4 (&acc)[2][2][4][2], const Unit& u, int wr, int wc, int fr, int fq) const {
        const int row0 = u.pm * BM + wr * 64 + fr, col0 = u.pn * BM + wc * 32 + 8 * fq;
        f32x4 sc[2][2];
#pragma unroll
        for (int bj = 0; bj < 2; ++bj) { sc[bj][0] = *(const PG8_LAS f32x4*)(tab + u.par * 512 + 256 + wc * 32 + 8 * fq + bj * HALF); sc[bj][1] = *(const PG8_LAS f32x4*)(tab + u.par * 512 + 256 + wc * 32 + 8 * fq + bj * HALF + 4); }
#pragma unroll
        for (int ai = 0; ai < 2; ++ai)
#pragma unroll
            for (int m = 0; m < 4; ++m) { const int r = row0 + ai * HALF + m * 16; const float rs = tab[u.par * 512 + wr * 64 + fr + ai * HALF + m * 16]; bf16_t* rowp = O + (size_t)r * ldc + col0;
#pragma unroll
                for (int bj = 0; bj < 2; ++bj) { f32x4 v0, v1;
#pragma unroll
                    for (int j = 0; j < 4; ++j) { v0[j] = (float)acc[ai][bj][m][0][j] * (rs * sc[bj][0][j]); v1[j] = (float)acc[ai][bj][m][1][j] * (rs * sc[bj][1][j]); }
                    u32x4 w; w.x = cvt_pk_bf16(v0[0], v0[1]); w.y = cvt_pk_bf16(v0[2], v0[3]); w.z = cvt_pk_bf16(v1[0], v1[1]); w.w = cvt_pk_bf16(v1[2], v1[3]);
                    *(u32x4*)(rowp + bj * HALF) = w; } }
    }
};
struct EpiSwigluI8 {
    static constexpr bool PERM = true, AFTER_DRAIN = false;
    bf16_t* O; int ldc; const float* rsd; const float* wsc; int wstride; PG8_LAS float* tab;
    __device__ __forceinline__ void pre(const Unit& u, int tid, int wid) const { const float* src = tid < 256 ? rsd + u.pm * BM + tid : wsc + (size_t)u.e * wstride + u.pn * BM + (tid - 256);
        __builtin_amdgcn_global_load_lds((const unsigned*)src, (PG8_LAS unsigned*)(tab + u.par * 512 + wid * 64), 4, 0, 0); }
    __device__ __forceinline__ void operator()(const i32x4 (&acc)[2][2][4][2], const Unit& u, int wr, int wc, int fr, int fq) const {
        const int row0 = u.pm * BM + wr * 64 + fr, col0 = u.pn * HALF + wc * 32 + 8 * fq;
        const PG8_LAS float* ws_ = tab + u.par * 512 + 256 + wc * 32 + 8 * fq;
        const f32x4 sg0 = *(const PG8_LAS f32x4*)ws_, sg1 = *(const PG8_LAS f32x4*)(ws_ + 4), su0 = *(const PG8_LAS f32x4*)(ws_ + HALF), su1 = *(const PG8_LAS f32x4*)(ws_ + HALF + 4);
#pragma unroll
        for (int ai = 0; ai < 2; ++ai)
#pragma unroll
            for (int m = 0; m < 4; ++m) { const int r = row0 + ai * HALF + m * 16; const float rs = tab[u.par * 512 + wr * 64 + fr + ai * HALF + m * 16];
                float o[8];
#pragma unroll
                for (int n = 0; n < 2; ++n)
#pragma unroll
                    for (int j = 0; j < 4; ++j) { const float g = (float)acc[ai][0][m][n][j] * (rs * (n ? sg1[j] : sg0[j])), up = (float)acc[ai][1][m][n][j] * (rs * (n ? su1[j] : su0[j])); o[4 * n + j] = g * up * __builtin_amdgcn_rcpf(1.0f + __expf(-g)); }
                u32x4 w; w.x = cvt_pk_bf16(o[0], o[1]); w.y = cvt_pk_bf16(o[2], o[3]); w.z = cvt_pk_bf16(o[4], o[5]); w.w = cvt_pk_bf16(o[6], o[7]);
                *(u32x4*)(O + (size_t)r * ldc + col0) = w; }
    }
};
template <> struct EpiPre<EpiScaleI8> { static constexpr bool v = true; };
template <> struct EpiPre<EpiSwigluI8> { static constexpr bool v = true; };
struct EpiSwiglu {
    static constexpr bool PERM = true, AFTER_DRAIN = false;
    bf16_t* O; int ldc; const float* ssq; const float* rsd;
    __device__ __forceinline__ void operator()(const f32x4 (&acc)[2][2][4][2], const Unit& u, int wr, int wc, int fr, int fq) const {
        const int row0 = u.pm * BM + wr * 64 + fr, col0 = u.pn * HALF + wc * 32 + 8 * fq;
#pragma unroll
        for (int ai = 0; ai < 2; ++ai)
#pragma unroll
            for (int m = 0; m < 4; ++m) { const int r = row0 + ai * HALF + m * 16; const float rs = rsd ? rsd[r] : rstd16(ssq, r);
                float o[8];
#pragma unroll
                for (int n = 0; n < 2; ++n)
#pragma unroll
                    for (int j = 0; j < 4; ++j) { const float g = acc[ai][0][m][n][j] * rs, up = acc[ai][1][m][n][j] * rs; o[4 * n + j] = g * up * __builtin_amdgcn_rcpf(1.0f + __expf(-g)); }
                u32x4 w; w.x = cvt_pk_bf16(o[0], o[1]); w.y = cvt_pk_bf16(o[2], o[3]); w.z = cvt_pk_bf16(o[4], o[5]); w.w = cvt_pk_bf16(o[6], o[7]);
                *(u32x4*)(O + (size_t)r * ldc + col0) = w; }
    }
};
template <class Epi, class Sched, bool ALIGN_EPI = false, bool SP2 = false, bool I8 = false>
__device__ __forceinline__ void gemm_phase(PG8_LAS unsigned char* lds, const Gemm g, const Sched& S, const Epi& E, int wave_in) {
    int wid_ = wave_in; unsigned ones_ = ~0u; asm volatile("" : "+s"(wid_), "+s"(ones_));
    const int wid = wid_, lane = (int)__builtin_amdgcn_mbcnt_hi(ones_, __builtin_amdgcn_mbcnt_lo(ones_, 0u)), tid = wid * 64 + lane, wr = wid >> 2, wc = wid & 3, fr = lane & 15, fq = lane >> 4;
    int K_ = g.K; asm volatile("" : "+s"(K_)); const int K = K_, nt = K / BK;
    unsigned voffA[2], voffB[2];
#pragma unroll
    for (int i = 0; i < 2; ++i) { int R, C; stage_rc(tid * 16 + i * 8192, R, C); const int Rb = Epi::PERM ? ((R & ~31) + perm32(R & 31)) : R;
        voffA[i] = (unsigned)(R * g.lda + C) * 2u; voffB[i] = (unsigned)(Rb * g.ldb + C) * 2u; }
    const size_t kstep = (size_t)(BK * 2);
    const size_t hstepA = (size_t)HALF * g.lda * 2, hstepB = (size_t)HALF * g.ldb * 2;
    const unsigned ldsw = (unsigned)wid * 1024u;
    const int aoff = lds_byte(wr * 64 + fr, fq * 8), boff = lds_byte(wc * 32 + fr, fq * 8);
#define PG8_SA(b, h) (((b) * 2 + (h)) * HTB)
#define PG8_SB(b, h) ((4 + (b) * 2 + (h)) * HTB)
#define PG8_STAGE(bufoff, gbase, voff) do { _Pragma("unroll") for (int _i = 0; _i < 2; ++_i) \
        __builtin_amdgcn_global_load_lds((const unsigned*)((const char*)(gbase) + (voff)[_i]), (PG8_LAS unsigned*)(lds + (bufoff) + ldsw + _i * 8192), 16, 0, 0); } while (0)
#define PG8_LDA(dst, b, h) do { _Pragma("unroll") for (int m = 0; m < 4; ++m) _Pragma("unroll") for (int k = 0; k < 2; ++k) dst[m][k] = *(const PG8_LAS bf16x8*)(lds + PG8_SA(b, h) + aoff + m * 2048 + k * 1024); } while (0)
#define PG8_LDA_H(dst, b, h, m0) do { _Pragma("unroll") for (int m = (m0); m < (m0) + 2; ++m) _Pragma("unroll") for (int k = 0; k < 2; ++k) dst[m][k] = *(const PG8_LAS bf16x8*)(lds + PG8_SA(b, h) + aoff + m * 2048 + k * 1024); } while (0)
#define PG8_LDB(dst, b, h) do { _Pragma("unroll") for (int n = 0; n < 2; ++n) _Pragma("unroll") for (int k = 0; k < 2; ++k) dst[n][k] = *(const PG8_LAS bf16x8*)(lds + PG8_SB(b, h) + boff + n * 2048 + k * 1024); } while (0)
#define PG8_MMA(ai, bj, At, Bt) do { __builtin_amdgcn_s_setprio(1); _Pragma("unroll") for (int m = 0; m < 4; ++m) _Pragma("unroll") for (int n = 0; n < 2; ++n) _Pragma("unroll") for (int k = 0; k < 2; ++k) \
        acc[ai][bj][m][n] = mma1<I8>(Bt[n][k], At[m][k], acc[ai][bj][m][n]); __builtin_amdgcn_s_setprio(0); } while (0)
#define PG8_WAIT_V(n) asm volatile("s_waitcnt vmcnt(" #n ")" ::: "memory")
#define PG8_WAIT_L(n) asm volatile("s_waitcnt lgkmcnt(" #n ")" ::: "memory")
#define PG8_BAR __builtin_amdgcn_s_barrier()
#define PG8_SCHED __builtin_amdgcn_sched_barrier(0)
    Unit cur, nxt; int ui = 0;
    if (!S.next(0, cur)) return;
    typedef typename AccSel<I8>::T AccV; AccV acc[2][2][4][2];
#pragma unroll
    for (int a = 0; a < 2; ++a)
#pragma unroll
        for (int b = 0; b < 2; ++b)
#pragma unroll
            for (int m = 0; m < 4; ++m)
#pragma unroll
                for (int n = 0; n < 2; ++n) { AccV z_{}; acc[a][b][m][n] = z_; }
    bf16x8 At[4][2], B0[2][2], B1[2][2];
    const char* cA = (const char*)g.A + cur.aoff; const char* cB = (const char*)g.Bt + cur.boff;
    S.a_ready(cur);
    if constexpr (SP2) {
        PG8_STAGE(PG8_SB(0, 0), cB, voffB); PG8_STAGE(PG8_SB(0, 1), cB + hstepB, voffB); PG8_STAGE(PG8_SA(0, 0), cA, voffA); PG8_STAGE(PG8_SA(0, 1), cA + hstepA, voffA);
        if (wr == 1) PG8_BAR;
        PG8_WAIT_V(2); PG8_BAR;
        PG8_STAGE(PG8_SB(1, 0), cB + kstep, voffB); PG8_STAGE(PG8_SA(1, 0), cA + kstep, voffA); PG8_STAGE(PG8_SB(1, 1), cB + hstepB + kstep, voffB);
        PG8_WAIT_V(6); PG8_BAR;
    } else {
        PG8_STAGE(PG8_SB(0, 0), cB, voffB); PG8_STAGE(PG8_SA(0, 0), cA, voffA); PG8_STAGE(PG8_SB(0, 1), cB + hstepB, voffB); PG8_STAGE(PG8_SA(0, 1), cA + hstepA, voffA);
        if (wr == 1) PG8_BAR;
        PG8_WAIT_V(4); PG8_BAR;
        PG8_STAGE(PG8_SB(1, 0), cB + kstep, voffB); PG8_STAGE(PG8_SA(1, 0), cA + kstep, voffA); PG8_STAGE(PG8_SB(1, 1), cB + hstepB + kstep, voffB);
        PG8_WAIT_V(6); PG8_BAR;
    }
    for (;;) {
        const bool has_next = S.next(ui + 1, nxt);
        const char* nA = has_next ? (const char*)g.A + nxt.aoff : cA; const char* nB = has_next ? (const char*)g.Bt + nxt.boff : cB;
        cur.par = ui & 1; if constexpr (EpiPre<Epi>::v) E.pre(cur, tid, wid);
        for (int t = 0; t < nt; t += 2) {
            const bool last = (t == nt - 2);
            const char* a1 = cA + (size_t)(t + 1) * kstep;
            const char* a2 = last ? nA : cA + (size_t)(t + 2) * kstep; const char* b2 = last ? nB : cB + (size_t)(t + 2) * kstep;
            const char* a3 = a2 + kstep; const char* b3 = b2 + kstep;
            if (last && has_next) S.a_ready(nxt);
            if constexpr (SP2) {
            PG8_LDB(B0, 0, 0); PG8_LDB(B1, 0, 1); PG8_SCHED; PG8_LDA_H(At, 0, 0, 0); PG8_WAIT_L(8); PG8_LDA_H(At, 0, 0, 2); PG8_STAGE(PG8_SA(1, 1), a1 + hstepA, voffA);
            PG8_WAIT_V(8); PG8_WAIT_L(0); PG8_BAR; PG8_MMA(0, 0, At, B0); PG8_MMA(0, 1, At, B1); PG8_BAR; PG8_SCHED;
            PG8_LDA(At, 0, 1); PG8_STAGE(PG8_SB(0, 0), b2, voffB); PG8_STAGE(PG8_SB(0, 1), b2 + hstepB, voffB); PG8_STAGE(PG8_SA(0, 0), a2, voffA);
            PG8_WAIT_V(8); PG8_WAIT_L(0); PG8_BAR; PG8_MMA(1, 0, At, B0); PG8_MMA(1, 1, At, B1); PG8_BAR; PG8_SCHED;
            PG8_LDB(B0, 1, 0); PG8_LDB(B1, 1, 1); PG8_SCHED; PG8_LDA_H(At, 1, 0, 0); PG8_WAIT_L(8); PG8_LDA_H(At, 1, 0, 2); PG8_STAGE(PG8_SA(0, 1), a2 + hstepA, voffA);
            PG8_WAIT_V(8); PG8_WAIT_L(0); PG8_BAR; PG8_MMA(0, 0, At, B0); PG8_MMA(0, 1, At, B1); PG8_BAR; PG8_SCHED;
            PG8_LDA(At, 1, 1); PG8_STAGE(PG8_SB(1, 0), b3, voffB); PG8_STAGE(PG8_SB(1, 1), b3 + hstepB, voffB); PG8_STAGE(PG8_SA(1, 0), a3, voffA);
            PG8_WAIT_V(8); PG8_WAIT_L(0); PG8_BAR; PG8_MMA(1, 0, At, B0); PG8_MMA(1, 1, At, B1); PG8_BAR; PG8_SCHED;
            } else {
            PG8_LDB(B0, 0, 0); PG8_SCHED; PG8_LDA(At, 0, 0); PG8_STAGE(PG8_SA(1, 1), a1 + hstepA, voffA);
            PG8_WAIT_L(8); PG8_BAR; PG8_WAIT_L(0); PG8_MMA(0, 0, At, B0); PG8_BAR; PG8_SCHED;
            PG8_LDB(B1, 0, 1); PG8_STAGE(PG8_SB(0, 0), b2, voffB);
            PG8_BAR; PG8_WAIT_L(0); PG8_MMA(0, 1, At, B1); PG8_BAR;
            PG8_LDA(At, 0, 1); PG8_STAGE(PG8_SA(0, 0), a2, voffA);
            PG8_BAR; PG8_WAIT_L(0); PG8_MMA(1, 0, At, B0); PG8_BAR; PG8_SCHED;
            PG8_STAGE(PG8_SB(0, 1), b2 + hstepB, voffB);
            PG8_WAIT_V(6); PG8_BAR; PG8_MMA(1, 1, At, B1); PG8_BAR;
            PG8_LDB(B0, 1, 0); PG8_SCHED; PG8_LDA(At, 1, 0); PG8_STAGE(PG8_SA(0, 1), a2 + hstepA, voffA);
            PG8_WAIT_L(8); PG8_BAR; PG8_WAIT_L(0); PG8_MMA(0, 0, At, B0); PG8_BAR; PG8_SCHED;
            PG8_LDB(B1, 1, 1); PG8_STAGE(PG8_SB(1, 0), b3, voffB);
            PG8_BAR; PG8_WAIT_L(0); PG8_MMA(0, 1, At, B1); PG8_BAR;
            PG8_LDA(At, 1, 1); PG8_STAGE(PG8_SA(1, 0), a3, voffA);
            PG8_BAR; PG8_WAIT_L(0); PG8_MMA(1, 0, At, B0); PG8_BAR; PG8_SCHED;
            PG8_STAGE(PG8_SB(1, 1), b3 + hstepB, voffB);
            PG8_WAIT_V(6); PG8_BAR; PG8_MMA(1, 1, At, B1); PG8_BAR;
            }
        }
        if constexpr (ALIGN_EPI) { if (wr == 0) PG8_BAR; }
        if constexpr (!Epi::AFTER_DRAIN) { E(acc, cur, wr, wc, fr, fq); S.done(cur); }
        if (!has_next) break;
#pragma unroll
        for (int a = 0; a < 2; ++a)
#pragma unroll
            for (int b = 0; b < 2; ++b)
#pragma unroll
                for (int m = 0; m < 4; ++m)
#pragma unroll
                    for (int n = 0; n < 2; ++n) { AccV z_{}; acc[a][b][m][n] = z_; }
        cur = nxt; cA = nA; cB = nB; ++ui;
        if constexpr (ALIGN_EPI) { if (wr == 1) PG8_BAR; }
    }
    PG8_WAIT_V(0);
    if constexpr (!ALIGN_EPI) { if (wr == 0) PG8_BAR; }
    PG8_BAR;
    if constexpr (Epi::AFTER_DRAIN) { E.fused(acc, cur, wr, wc, fr, fq, lds, wid, lane); S.done(cur); }
#undef PG8_SA
#undef PG8_SB
#undef PG8_STAGE
#undef PG8_LDA
#undef PG8_LDB
#undef PG8_MMA
#undef PG8_WAIT_V
#undef PG8_WAIT_L
#undef PG8_BAR
#undef PG8_SCHED
}
}

#define XB_TMO      128
#define XB_XCNT(j)  (256  + 64 * (j))
#define XB_XSUB(j)  (1280 + 64 * (j))
#define XB_XGEN(j)  (2304 + 64 * (j))
#define XB_TOP      3328
#define XB_TOPGEN   3392
#define XCD_BAR_WORDS 3456
#define XB_SPIN_CAP (1u << 22)
#define LAS __attribute__((address_space(3)))

__device__ __forceinline__ unsigned xb_ld(unsigned* p)              { return __hip_atomic_load(p, __ATOMIC_RELAXED, __HIP_MEMORY_SCOPE_AGENT); }
__device__ __forceinline__ unsigned xb_add(unsigned* p, unsigned v) { return __hip_atomic_fetch_add(p, v, __ATOMIC_RELAXED, __HIP_MEMORY_SCOPE_AGENT); }
__device__ __forceinline__ unsigned xb_xcc_id() { return (unsigned)__builtin_amdgcn_s_getreg((3 << 11) | 20) & 0xFu; }
#define XB_SPIN(cond, bar) do { unsigned _sp = 0; while (cond) { __builtin_amdgcn_s_sleep(1); \
    if ((++_sp & 255u) == 0u) { if (xb_ld(&(bar)[XB_TMO])) break; if (_sp > XB_SPIN_CAP) { atomicAdd(&(bar)[XB_TMO], 1u); break; } } } } while (0)

struct XcdBarrier {
    unsigned* bar; unsigned x;
    volatile LAS unsigned* st;
};

__device__ __forceinline__ XcdBarrier xcd_barrier_post(unsigned* bar, volatile LAS unsigned* st) {
    XcdBarrier b; b.bar = bar; b.x = xb_xcc_id(); b.st = st;
    if (threadIdx.x == 0) (void)xb_add(&bar[XB_XCNT(b.x)], 1u);
    return b;
}
__device__ __forceinline__ void xcd_barrier_complete(unsigned* bar, unsigned x, unsigned& nloc, unsigned& nx) {
    const unsigned G = gridDim.x * gridDim.y * gridDim.z;
    unsigned sum, cnt, mine, sp = 0u;
    for (;;) {
        sum = 0u; cnt = 0u; mine = 0u;
#pragma unroll
        for (unsigned j = 0; j < 16; ++j) { const unsigned c = xb_ld(&bar[XB_XCNT(j)]); sum += c; cnt += (c > 0u) ? 1u : 0u; mine = (j == x) ? c : mine; }
        if (sum == G) break;
        __builtin_amdgcn_s_sleep(1);
        if ((++sp & 255u) == 0u) { if (xb_ld(&bar[XB_TMO])) break; if (sp > XB_SPIN_CAP) { atomicAdd(&bar[XB_TMO], 1u); break; } }
    }
    nloc = mine > 0u ? mine : 1u; nx = cnt > 0u ? cnt : 1u;
}

__device__ __forceinline__ void xcd_barrier(const XcdBarrier& b) {
    asm volatile("s_waitcnt vmcnt(0)" ::: "memory");
    __syncthreads();
    if (threadIdx.x == 0) {
        unsigned* bar = b.bar;
        __builtin_amdgcn_s_waitcnt(0);
        unsigned nloc = b.st[0], nx = b.st[1];
        if (nloc == 0u) { xcd_barrier_complete(bar, b.x, nloc, nx); b.st[0] = nloc; b.st[1] = nx; }
        const unsigned old = xb_add(&bar[XB_XSUB(b.x)], 1u);
        const unsigned gen = old / nloc;
        if (old + 1u == (gen + 1u) * nloc) {
            __builtin_amdgcn_fence(__ATOMIC_RELEASE, "agent");
            asm volatile("s_waitcnt vmcnt(0)" ::: "memory");
            const unsigned og = xb_add(&bar[XB_TOP], 1u);
            const unsigned tg = og / nx;
            if (og + 1u == (tg + 1u) * nx) xb_add(&bar[XB_TOPGEN], 1u);
            else XB_SPIN(xb_ld(&bar[XB_TOPGEN]) == tg, bar);
            __builtin_amdgcn_fence(__ATOMIC_ACQUIRE, "agent");
            xb_add(&bar[XB_XGEN(b.x)], 1u);
            asm volatile("s_waitcnt vmcnt(0)" ::: "memory");
        } else {
            XB_SPIN(xb_ld(&bar[XB_XGEN(b.x)]) == gen, bar);
            __builtin_amdgcn_fence(__ATOMIC_ACQUIRE, "agent");
            asm volatile("s_waitcnt vmcnt(0)" ::: "memory");
        }
    }
    __syncthreads();
}

constexpr int NB = 16, SEQ = 2048, DM = 1024, NL = 4, MEMLEN = 256, INC = 2816, FF = 2816, NEXP = 8;
constexpr int T = NB * SEQ;
constexpr int MROWS = NB * MEMLEN;
constexpr int MOE_ROWS = 2 * T + NEXP * 256;
constexpr int O_RET = 256, O_SB = 1280;
constexpr float NORM_EPS = 1e-6f;

constexpr size_t MiB = 1u << 20;
constexpr size_t WS_CTL = 0;
constexpr size_t WS_SSQ = 1 * MiB;
constexpr size_t WS_ROPE = 3 * MiB;
constexpr size_t WS_WR = 3 * MiB + 512 * 1024;
constexpr size_t WS_MOEI = 4 * MiB;
constexpr size_t WS_MEMN = 8 * MiB;
constexpr size_t WS_KC = 16 * MiB;
constexpr size_t WS_VT = 48 * MiB;
constexpr size_t WS_H = 80 * MiB;
constexpr size_t WS_WIN = 144 * MiB, WS_WGLU = 166 * MiB, WS_WOUT = 167 * MiB, WS_WCQ = 175 * MiB, WS_WCK = 183 * MiB, WS_WCV = 191 * MiB, WS_WCO = 199 * MiB;
constexpr size_t WS_WDGU = 207 * MiB, WS_WDDN = 229 * MiB, WS_WEGU = 240 * MiB, WS_WEDN = 416 * MiB;
constexpr size_t WS_AR = 504 * MiB;
constexpr size_t AR_PROJ = WS_AR, AR_Y = WS_AR + 176 * MiB, AR_G = WS_AR + 240 * MiB, AR_Z = WS_AR + 256 * MiB, AR_XS = WS_AR + 272 * MiB;
constexpr size_t AR_QC = WS_AR, AR_SC = WS_AR + 64 * MiB, AR_PB = WS_AR + 192 * MiB, AR_OC = WS_AR + 256 * MiB;
constexpr size_t AR_ACT = WS_AR;
constexpr size_t AR_XG = WS_AR, AR_ACTG = WS_AR + 132 * MiB, AR_DG = WS_AR + 495 * MiB;
constexpr size_t WS_WK = WS_AR + 627 * MiB;
constexpr size_t WS_VO = WS_WK + 32 * MiB;
constexpr size_t WS_Q8W = WS_VO + 32 * MiB;
constexpr size_t WS_Q8S = WS_Q8W + 100 * MiB;
constexpr size_t WS_Q8IN = WS_Q8S + 1 * MiB;
constexpr size_t WS_Q8INS = WS_Q8IN + 11 * MiB;
constexpr size_t WS_END = WS_Q8INS + 1 * MiB;
static_assert((size_t)18 * 2 * FF * DM <= 100 * MiB, "int8 weight region");
static_assert((size_t)T * INC * 2 <= 176 * MiB && (size_t)T * 16 * 128 * 4 <= 256 * MiB && (size_t)MOE_ROWS * 1024 * 2 <= 132 * MiB && (size_t)MOE_ROWS * FF * 2 <= 363 * MiB, "arena map");
constexpr size_t MI_CNT = 0, MI_EST = 16384, MI_TOPI = 32768, MI_TOPG = MI_TOPI + (size_t)T * 8, MI_RSTD = MI_TOPG + (size_t)T * 8, MI_POS = MI_RSTD + (size_t)T * 4, MI_RSTDG = MI_POS + (size_t)T * 8, MI_RSC0 = 2 * MiB;
static_assert(MI_RSTDG + (size_t)MOE_ROWS * 4 <= 2 * MiB && MI_RSC0 + (size_t)T * 4 <= 4 * MiB, "moe tables");

constexpr int RING_BYTES = 131072;
constexpr int MISC_OFF = RING_BYTES + 320;
constexpr int TAB_OFF = MISC_OFF + 128;
constexpr int LDS_BYTES = 147456;

#define GAS __attribute__((address_space(1)))
typedef unsigned short bf16;
typedef unsigned v4u __attribute__((ext_vector_type(4)));
typedef unsigned v2u __attribute__((ext_vector_type(2)));
typedef float f32x4 __attribute__((ext_vector_type(4)));
__device__ __forceinline__ float bf2f(unsigned v) { return __uint_as_float(v << 16); }
__device__ __forceinline__ float bflo(unsigned w) { return __uint_as_float(w << 16); }
__device__ __forceinline__ float bfhi(unsigned w) { return __uint_as_float(w & 0xffff0000u); }
__device__ __forceinline__ unsigned f2bf(float f) { unsigned u = __float_as_uint(f); return (u + 0x7fffu + ((u >> 16) & 1u)) >> 16; }
__device__ __forceinline__ unsigned pk2(float lo, float hi) { return f2bf(lo) | (f2bf(hi) << 16); }
__device__ __forceinline__ float wave_sum(float v) {
#pragma unroll
    for (int o = 1; o < 64; o <<= 1) v += __shfl_xor(v, o);
    return v;
}
__device__ __forceinline__ float wave_max(float v) {
#pragma unroll
    for (int o = 1; o < 64; o <<= 1) v = fmaxf(v, __shfl_xor(v, o));
    return v;
}
__device__ __forceinline__ void unpack8(const v4u w, float* f) { f[0] = bflo(w.x); f[1] = bfhi(w.x); f[2] = bflo(w.y); f[3] = bfhi(w.y); f[4] = bflo(w.z); f[5] = bfhi(w.z); f[6] = bflo(w.w); f[7] = bfhi(w.w); }
__device__ __forceinline__ void load64(const bf16* p, float* f) {
#pragma unroll
    for (int i = 0; i < 8; ++i) unpack8(((const v4u*)p)[i], f + 8 * i);
}
__device__ __forceinline__ float rstd16(const float* ssq, int r) { return pg8::rstd16(ssq, r); }

struct P { const float* in[27]; float* out; unsigned char* ws; int ph_lo, ph_hi; };
typedef const __attribute__((address_space(4))) P* KP;

__device__ __forceinline__ v2u q8_pack8(const float* v, float inv) { unsigned b[8];
#pragma unroll
    for (int j = 0; j < 8; ++j) b[j] = (unsigned)(int)__builtin_rintf(v[j] * inv) & 0xffu;
    v2u o; o.x = b[0] | (b[1] << 8) | (b[2] << 16) | (b[3] << 24); o.y = b[4] | (b[5] << 8) | (b[6] << 16) | (b[7] << 24); return o; }
__device__ __forceinline__ float absmax16(const float* a, const float* b) { float m = 0.f;
#pragma unroll
    for (int j = 0; j < 8; ++j) m = fmaxf(m, fmaxf(fabsf(a[j]), fabsf(b[j])));
    return wave_max(m); }

struct TrD { const float* W; bf16* WT; const float* wn; float sc; int ldw, K, mode, k0, n0; };
__device__ __forceinline__ TrD tr_desc(KP p, GAS unsigned char* ws, int it) {
    constexpr int I_GLU = 4 * 1, I_SQ = 16 * 4, I_DN = 44 * 4;
    constexpr int E0 = 0, E1 = E0 + 4 * I_GLU, E2 = E1 + 4 * I_SQ, E3 = E2, E4 = E3 + 4 * I_SQ, E5 = E4 + 4 * I_SQ, E6 = E5 + 4 * I_SQ, E8 = E6 + 2 * I_DN;
    TrD d; d.wn = nullptr; d.sc = 1.f; d.mode = 0; int item, N;
    if (it < E1) { const int r = it - E0, l = r / I_GLU; item = r % I_GLU; d.W = ((const float*)(GAS const float*)p->in[12]) + (size_t)l * 256 * 256; d.ldw = 256; d.K = 256; N = 256; d.WT = (bf16*)(ws + WS_WGLU) + (size_t)l * 256 * 256; }
    else if (it < E2) { const int r = it - E1, l = r / I_SQ; item = r % I_SQ; d.W = ((const float*)(GAS const float*)p->in[14]) + (size_t)l * DM * DM; d.ldw = DM; d.K = DM; N = DM; d.WT = (bf16*)(ws + WS_WOUT) + (size_t)l * DM * DM; }
    else if (it < E4) { const int r = it - E3, l = r / I_SQ; item = r % I_SQ; d.W = ((const float*)(GAS const float*)p->in[18]) + (size_t)l * DM * 2 * DM; d.ldw = 2 * DM; d.K = DM; N = DM; d.WT = (bf16*)(ws + WS_WCK) + (size_t)l * DM * DM; }
    else if (it < E5) { const int r = it - E4, l = r / I_SQ; item = r % I_SQ; d.W = ((const float*)(GAS const float*)p->in[18]) + (size_t)l * DM * 2 * DM + DM; d.ldw = 2 * DM; d.K = DM; N = DM; d.WT = (bf16*)(ws + WS_WCV) + (size_t)l * DM * DM; }
    else if (it < E6) { const int r = it - E5, l = r / I_SQ; item = r % I_SQ; d.W = ((const float*)(GAS const float*)p->in[19]) + (size_t)l * DM * DM; d.ldw = DM; d.K = DM; N = DM; d.WT = (bf16*)(ws + WS_WCO) + (size_t)l * DM * DM; }
    else if (it < E8) { const int r = it - E6, i = r / I_DN; item = r % I_DN; d.W = ((const float*)(GAS const float*)p->in[22]) + (size_t)i * FF * DM; d.ldw = DM; d.K = FF; N = DM; d.WT = (bf16*)(ws + WS_WDDN) + (size_t)i * DM * FF; }
    else              { const int r = it - E8, ie = r / I_DN; item = r % I_DN; d.W = ((const float*)(GAS const float*)p->in[25]) + (size_t)ie * FF * DM; d.ldw = DM; d.K = FF; N = DM; d.WT = (bf16*)(ws + WS_WEDN) + (size_t)ie * DM * FF; }
    const int nblk = N / 256; d.k0 = 64 * (item / nblk); d.n0 = 256 * (item % nblk);
    return d;
}
constexpr int TR_TOTAL = 4 * 4 + 4 * 4 * 64 + 2 * 176 + 16 * 176;
__device__ __forceinline__ void tr_load(const TrD& d, f32x4 (&v)[8], int tid) {
    const float* src = d.W + (size_t)(d.k0 + (tid >> 6)) * d.ldw + d.n0 + 4 * (tid & 63);
#pragma unroll
    for (int i = 0; i < 8; ++i) v[i] = *(const f32x4*)(src + (size_t)(8 * i) * d.ldw);
}
struct SqD { const float* W; const float* wn; unsigned char* Q; float* QS; int ldw, n0, dr0; };
constexpr int SQ_GU = 18 * 176, SQ_TOTAL = SQ_GU + 4 * 88;
__device__ __forceinline__ SqD sq_desc(KP p, GAS unsigned char* ws, int s) {
    SqD d;
    if (s < SQ_GU) { const int m = s / 176, j = s % 176; const int n = 32 * j, jj = n >= FF ? n - FF : n; d.n0 = n; d.ldw = 2 * FF; d.dr0 = (jj / 128) * 256 + (jj % 128) + (n >= FF ? 128 : 0);
        if (m < 2) { d.W = ((const float*)(GAS const float*)p->in[21]) + (size_t)m * DM * 2 * FF; d.wn = ((const float*)(GAS const float*)p->in[20]) + (2 * m) * DM; }
        else { const int ie = m - 2; d.W = ((const float*)(GAS const float*)p->in[24]) + (size_t)ie * DM * 2 * FF; d.wn = ((const float*)(GAS const float*)p->in[20]) + (2 * (ie / NEXP) + 1) * DM; }
        d.Q = (unsigned char*)(ws + WS_Q8W) + (size_t)m * 2 * FF * DM; d.QS = (float*)(ws + WS_Q8S) + (size_t)m * 2 * FF; }
    else { const int r = s - SQ_GU, l = r / 88, j = r % 88; d.n0 = 32 * j; d.dr0 = 32 * j; d.ldw = INC; d.W = ((const float*)(GAS const float*)p->in[3]) + (size_t)l * DM * INC; d.wn = ((const float*)(GAS const float*)p->in[2]) + l * DM;
        d.Q = (unsigned char*)(ws + WS_Q8IN) + (size_t)l * INC * DM; d.QS = (float*)(ws + WS_Q8INS) + (size_t)l * INC; }
    return d;
}
__device__ __forceinline__ void sq_load(const SqD& d, f32x4 (&v)[16], int tid) {
    const float* src = d.W + (size_t)(tid >> 3) * d.ldw + d.n0 + 4 * (tid & 7);
#pragma unroll
    for (int i = 0; i < 16; ++i) v[i] = *(const f32x4*)(src + (size_t)(64 * i) * d.ldw);
}
__device__ __forceinline__ void phase_prologue(KP p, GAS unsigned char* ws, LAS unsigned char* lds, int bid, int G, int gw, int NGW, int wave, int lane, int tid) {
    {   int it = bid; SqD cur, nxt; f32x4 v[16];
        if (it < SQ_TOTAL) { cur = sq_desc(p, ws, it); sq_load(cur, v, tid); }
        while (it < SQ_TOTAL) {
            { const int kr = tid >> 3, ch = tid & 7;
#pragma unroll
              for (int i = 0; i < 16; ++i) { const int k = 64 * i + kr; const float s = cur.wn[k]; LAS unsigned short* d = (LAS unsigned short*)(lds + (4 * ch) * 2048 + (((k >> 3) ^ ch) << 4) + 2 * (k & 7));
#pragma unroll
                  for (int e = 0; e < 4; ++e) d[e * 1024] = (unsigned short)f2bf(v[i][e] * s);
                  if ((i & 1) == 1) asm volatile("s_waitcnt lgkmcnt(0)" ::: "memory"); } }
            __syncthreads();
            const int itn = it + G;
            if (itn < SQ_TOTAL) { nxt = sq_desc(p, ws, itn); sq_load(nxt, v, tid); }
#pragma unroll
            for (int j = 0; j < 4; ++j) { const int row = 4 * wave + j; const LAS unsigned char* src = lds + row * 2048; float a[8], b2[8];
                unpack8(*(const LAS v4u*)(src + ((lane ^ wave) << 4)), a); unpack8(*(const LAS v4u*)(src + (((64 + lane) ^ wave) << 4)), b2);
                const float mx = absmax16(a, b2), step = mx > 0.f ? mx * (1.0f / 127.0f) : 1.0f, inv = 1.0f / step;
                unsigned char* qd = cur.Q + (size_t)(cur.dr0 + row) * DM;
                ((v2u*)qd)[lane] = q8_pack8(a, inv); ((v2u*)(qd + 512))[lane] = q8_pack8(b2, inv);
                if (lane == 0) cur.QS[cur.dr0 + row] = step; }
            __syncthreads();
            it = itn; cur = nxt;
        }
    }
    {   LAS float* T0 = (LAS float*)lds;
        int it = bid; TrD cur, nxt; f32x4 v[8];
        if (it < TR_TOTAL) { cur = tr_desc(p, ws, it); tr_load(cur, v, tid); }
        while (it < TR_TOTAL) {
            { const int r = tid >> 6, ch = tid & 63;
#pragma unroll
              for (int i = 0; i < 8; ++i) { const int k = 8 * i + r; const float s = cur.wn ? cur.wn[cur.k0 + k] * cur.sc : cur.sc; *(LAS f32x4*)(T0 + k * 256 + ((ch ^ (i & 7)) << 2)) = v[i] * s; } }
            __syncthreads();
            const int itn = it + G;
            if (itn < TR_TOTAL) { nxt = tr_desc(p, ws, itn); tr_load(nxt, v, tid); }
            { const int c = tid & 7;
#pragma unroll
              for (int j = 0; j < 4; ++j) { const int nn = (tid >> 3) + 64 * j; const LAS float* s = T0 + (8 * c) * 256 + ((((nn >> 2) ^ c) << 2) | (nn & 3));
                  v4u o; o.x = pk2(s[0 * 256], s[1 * 256]); o.y = pk2(s[2 * 256], s[3 * 256]); o.z = pk2(s[4 * 256], s[5 * 256]); o.w = pk2(s[6 * 256], s[7 * 256]);
                  const int n = cur.n0 + nn; int dr = n; if (cur.mode == 1) { const int jj = n >= FF ? n - FF : n; dr = (jj / 128) * 256 + (jj % 128) + (n >= FF ? 128 : 0); }
                  *(v4u*)(cur.WT + (size_t)dr * cur.K + cur.k0 + 8 * c) = o; } }
            __syncthreads();
            it = itn; cur = nxt;
        }
    }
    { const float* x = ((const float*)(GAS const float*)p->in[0]); bf16* H = (bf16*)(ws + WS_H); float* SSQ = (float*)(ws + WS_SSQ); unsigned char* HQ = (unsigned char*)(ws + AR_Y); float* RSC0 = (float*)(ws + WS_MOEI + MI_RSC0);
      for (int m = gw; m < T; m += NGW) { const f32x4* xr = (const f32x4*)(x + (size_t)m * DM) + lane; float s = 0.f, mx = 0.f; float hv[4][4];
#pragma unroll
          for (int j = 0; j < 4; ++j) { const f32x4 v = xr[64 * j]; const unsigned w0 = pk2(v[0], v[1]), w1 = pk2(v[2], v[3]);
              hv[j][0] = bflo(w0); hv[j][1] = bfhi(w0); hv[j][2] = bflo(w1); hv[j][3] = bfhi(w1);
#pragma unroll
              for (int e = 0; e < 4; ++e) { s += hv[j][e] * hv[j][e]; mx = fmaxf(mx, fabsf(hv[j][e])); }
              ((unsigned long long*)(H + (size_t)m * DM))[lane + 64 * j] = (unsigned long long)w0 | ((unsigned long long)w1 << 32); }
          s = wave_sum(s); mx = wave_max(mx); if (lane < 16) SSQ[(size_t)m * 16 + lane] = lane == 0 ? s : 0.f;
          const float step = mx > 0.f ? mx * (1.0f / 127.0f) : 1.0f, inv = 1.0f / step;
#pragma unroll
          for (int j = 0; j < 4; ++j) { unsigned q = 0u;
#pragma unroll
              for (int e = 0; e < 4; ++e) q |= ((unsigned)(int)__builtin_rintf(hv[j][e] * inv) & 0xffu) << (8 * e);
              ((unsigned*)(HQ + (size_t)m * DM))[lane + 64 * j] = q; }
          if (lane == 0) RSC0[m] = step / sqrtf(s * (1.0f / DM) + NORM_EPS); } }
    { const float* mem = ((const float*)(GAS const float*)p->in[1]); const float* w = ((const float*)(GAS const float*)p->in[16]); bf16* MN = (bf16*)(ws + WS_MEMN);
      for (int m = gw; m < MROWS; m += NGW) { const f32x4* xr = (const f32x4*)(mem + (size_t)m * DM) + lane; f32x4 v[4]; float s = 0.f;
#pragma unroll
          for (int j = 0; j < 4; ++j) { v[j] = xr[64 * j]; s += (v[j][0] * v[j][0] + v[j][1] * v[j][1]) + (v[j][2] * v[j][2] + v[j][3] * v[j][3]); }
          const float rs = 1.0f / sqrtf(wave_sum(s) * (1.0f / DM) + NORM_EPS);
#pragma unroll
          for (int j = 0; j < 4; ++j) { const f32x4 g = ((const f32x4*)w)[lane + 64 * j]; const unsigned w0 = pk2(v[j][0] * rs * g[0], v[j][1] * rs * g[1]), w1 = pk2(v[j][2] * rs * g[2], v[j][3] * rs * g[3]);
              ((unsigned long long*)(MN + (size_t)m * DM))[lane + 64 * j] = (unsigned long long)w0 | ((unsigned long long)w1 << 32); } } }
    { bf16* WQN = (bf16*)(ws + WS_WCQ); const float sc = 0.0625f * 1.4426950408889634f;
      for (size_t i8 = (size_t)gw * 64 + lane; i8 < (size_t)NL * DM * DM / 8; i8 += (size_t)NGW * 64) { const size_t e0 = i8 * 8; const int l = (int)(e0 / ((size_t)DM * DM)), k = (int)((e0 / DM) % DM);
          const f32x4 a = *(const f32x4*)(((const float*)(GAS const float*)p->in[17]) + e0), b2 = *(const f32x4*)(((const float*)(GAS const float*)p->in[17]) + e0 + 4); const float s = ((const float*)(GAS const float*)p->in[15])[l * DM + k] * sc;
          v4u o; o.x = pk2(a[0] * s, a[1] * s); o.y = pk2(a[2] * s, a[3] * s); o.z = pk2(b2[0] * s, b2[1] * s); o.w = pk2(b2[2] * s, b2[3] * s); *(v4u*)(WQN + e0) = o; } }
    { float* ROPE = (float*)(ws + WS_ROPE);
      for (int idx = gw * 64 + lane; idx < SEQ * 32; idx += NGW * 64) { const int pos = idx >> 5, i = idx & 31; const float invf = (float)pow(10000.0, -(double)i / 32.0); const float ang = (float)pos * invf;
          ROPE[2 * idx] = (float)cos((double)ang); ROPE[2 * idx + 1] = (float)sin((double)ang); }
      float* WR = (float*)(ws + WS_WR);
      for (int idx = gw * 64 + lane; idx < 2 * DM * NEXP; idx += NGW * 64) { const int i = idx / (DM * NEXP), k = (idx / NEXP) % DM; WR[idx] = ((const float*)(GAS const float*)p->in[23])[idx] * ((const float*)(GAS const float*)p->in[20])[(2 * i + 1) * DM + k]; } }
}


typedef short s16x8 __attribute__((ext_vector_type(8)));
typedef short s16x4 __attribute__((ext_vector_type(4)));
typedef _Float16 h16x8 __attribute__((ext_vector_type(8)));
typedef float f32x16 __attribute__((ext_vector_type(16)));
constexpr int AT_KSTR = 144, AT_VSTR = 136;
constexpr int AT_KS = 0, AT_VS = 2 * 64 * AT_KSTR, AT_FLAG = AT_VS + 2 * 64 * AT_VSTR, AT_SIN = AT_FLAG + 64, AT_UNIT = MISC_OFF + 64;
constexpr int RS_STR = 520, RS_KT = 0, RS_VT = 64 * RS_STR;
constexpr unsigned RS_UNITS = 64 * 7;
__device__ __forceinline__ int crow(int reg, int h) { return (reg & 3) + 8 * (reg >> 2) + 4 * h; }
__device__ __forceinline__ unsigned cvtpk_bf16(float lo, float hi) { unsigned r; asm volatile("v_cvt_pk_bf16_f32 %0, %1, %2" : "=v"(r) : "v"(lo), "v"(hi)); return r; }

template <int MODE>
__device__ __forceinline__ void attn_unit(const bf16* PROJ, bf16* Y, const float* ROPE, const float* gain, const float* SLOC, unsigned* ctrA, int bh, int qb, LAS unsigned char* lds, int wave, int lane, int tid) {
    constexpr int NH = MODE == 0 ? 8 : 4, QCOL = MODE == 0 ? O_SB : O_RET, KCOL = QCOL + (MODE == 0 ? 512 : 256), VCOL = KCOL + (MODE == 0 ? 512 : 256), YCOL = MODE == 0 ? 512 : 256;
    const int b = bh / NH, hd = bh % NH, r = lane & 31, h = lane >> 5;
    const int n0 = qb * 256 + wave * 32;
    const size_t rowb = (size_t)b * SEQ;
    s16x8 qf[4];
    { const bf16* qp = PROJ + (rowb + n0 + r) * INC + QCOL + hd * 64;
      float q[4][8];
#pragma unroll
      for (int s = 0; s < 4; ++s) unpack8(*(const v4u*)(qp + 16 * s + 8 * h), q[s]);
      if (MODE == 1) { const float* rp = ROPE + (size_t)(n0 + r) * 64;
#pragma unroll
          for (int s = 0; s < 2; ++s)
#pragma unroll
              for (int j = 0; j < 8; ++j) { const int i = 16 * s + 8 * h + j; const float cs = rp[2 * i], sn = rp[2 * i + 1]; const float x1 = q[s][j], x2 = q[s + 2][j]; q[s][j] = x1 * cs - x2 * sn; q[s + 2][j] = x1 * sn + x2 * cs; } }
      const float qs = MODE == 0 ? 0.125f * 1.4426950408889634f : 0.125f;
#pragma unroll
      for (int s = 0; s < 4; ++s) { v4u w; w.x = cvtpk_bf16(q[s][0] * qs, q[s][1] * qs); w.y = cvtpk_bf16(q[s][2] * qs, q[s][3] * qs); w.z = cvtpk_bf16(q[s][4] * qs, q[s][5] * qs); w.w = cvtpk_bf16(q[s][6] * qs, q[s][7] * qs); qf[s] = __builtin_bit_cast(s16x8, w); } }
    h16x8 uf[2];
    float dl[16]; float lg = 0.f;
    if (MODE == 0) {
#pragma unroll
        for (int s = 0; s < 2; ++s)
#pragma unroll
            for (int j = 0; j < 8; ++j) uf[s][j] = (16 * s + 8 * (j >> 2) + 4 * h + (j & 3)) >= r ? (_Float16)1.0f : (_Float16)0.0f;
    } else { lg = log2f(1.0f - exp2f(-5.0f - (float)hd));
#pragma unroll
        for (int i = 0; i < 16; ++i) dl[i] = exp2f(lg * (float)(r - crow(i, h))); }
    f32x16 o0, o1;
#pragma unroll
    for (int i = 0; i < 16; ++i) { o0[i] = 0.f; o1[i] = 0.f; }
    if (MODE == 1 && qb > 0) {
        if (tid == 0) { unsigned sp = 0; while (__hip_atomic_load(ctrA, __ATOMIC_RELAXED, __HIP_MEMORY_SCOPE_AGENT) < RS_UNITS) { __builtin_amdgcn_s_sleep(2); if (++sp > (1u << 22)) break; }
            __builtin_amdgcn_fence(__ATOMIC_ACQUIRE, "agent"); asm volatile("s_waitcnt vmcnt(0)" ::: "memory"); }
        __syncthreads();
        { float acc8[8];
#pragma unroll
          for (int j = 0; j < 8; ++j) acc8[j] = 0.f;
          const float g256 = exp2f(lg * 256.0f);
          for (int j = 0; j < qb; ++j) { const f32x4* sp4 = (const f32x4*)(SLOC + ((size_t)(bh * 7 + j) * 4096 + tid * 8)); const f32x4 s0 = sp4[0], s1 = sp4[1];
#pragma unroll
              for (int e = 0; e < 4; ++e) { acc8[e] = acc8[e] * g256 + s0[e]; acc8[4 + e] = acc8[4 + e] * g256 + s1[e]; } }
          v4u w; w.x = cvtpk_bf16(acc8[0], acc8[1]); w.y = cvtpk_bf16(acc8[2], acc8[3]); w.z = cvtpk_bf16(acc8[4], acc8[5]); w.w = cvtpk_bf16(acc8[6], acc8[7]);
          *(LAS v4u*)(lds + AT_SIN + (tid >> 3) * AT_KSTR + (tid & 7) * 16) = w; }
        __syncthreads();
        const LAS unsigned char* sb = lds + AT_SIN + r * AT_KSTR + 16 * h;
#pragma unroll
        for (int s = 0; s < 4; ++s) { const s16x8 a0 = *(const LAS s16x8*)(sb + 32 * s), a1 = *(const LAS s16x8*)(sb + 32 * AT_KSTR + 32 * s);
            o0 = __builtin_amdgcn_mfma_f32_32x32x16_bf16(a0, qf[s], o0, 0, 0, 0); o1 = __builtin_amdgcn_mfma_f32_32x32x16_bf16(a1, qf[s], o1, 0, 0, 0); }
        const float rsc = exp2f(lg * (float)(32 * wave + r + 1));
#pragma unroll
        for (int i = 0; i < 16; ++i) { o0[i] *= rsc; o1[i] *= rsc; }
    }
    float carry = 0.f; bool wdone = false;
    const int st_row = (tid & 255) >> 2, st_c = tid & 3; const bool st_k = tid < 256;
    const int kt_first = 4 * qb + 3, kt_lo = MODE == 1 ? 4 * qb : 0;
    struct SR { v4u g0, g1; f32x4 rp4[4]; };
    auto stage_load = [&](int kt, SR& R) { const bf16* src = PROJ + (rowb + 64 * kt + st_row) * INC + (st_k ? KCOL : VCOL) + hd * 64 + 8 * st_c; R.g0 = *(const v4u*)src; R.g1 = *(const v4u*)(src + 32);
        if (MODE == 1 && st_k) { const f32x4* rq = (const f32x4*)(ROPE + (size_t)(64 * kt + st_row) * 64 + 16 * st_c);
#pragma unroll
            for (int j = 0; j < 4; ++j) R.rp4[j] = rq[j]; } };
    auto stage_store = [&](int buf, SR& R) {
        v4u g0 = R.g0, g1 = R.g1;
        if (st_k) {
            if (MODE == 1) { float a[8], c2[8]; unpack8(g0, a); unpack8(g1, c2);
#pragma unroll
                for (int j = 0; j < 8; ++j) { const float cs = R.rp4[j >> 1][2 * (j & 1)], sn = R.rp4[j >> 1][2 * (j & 1) + 1]; const float x1 = a[j], x2 = c2[j]; a[j] = x1 * cs - x2 * sn; c2[j] = x1 * sn + x2 * cs; }
                g0.x = cvtpk_bf16(a[0], a[1]); g0.y = cvtpk_bf16(a[2], a[3]); g0.z = cvtpk_bf16(a[4], a[5]); g0.w = cvtpk_bf16(a[6], a[7]);
                g1.x = cvtpk_bf16(c2[0], c2[1]); g1.y = cvtpk_bf16(c2[2], c2[3]); g1.z = cvtpk_bf16(c2[4], c2[5]); g1.w = cvtpk_bf16(c2[6], c2[7]); }
            LAS unsigned char* d = lds + AT_KS + buf * 64 * AT_KSTR + st_row * AT_KSTR + 16 * st_c; *(LAS v4u*)d = g0; *(LAS v4u*)(d + 64) = g1;
        } else {
            LAS unsigned short* d = (LAS unsigned short*)(lds + AT_VS + buf * 64 * AT_VSTR + (8 * st_c) * AT_VSTR + 2 * st_row);
            const unsigned w0[4] = {g0.x, g0.y, g0.z, g0.w}, w1[4] = {g1.x, g1.y, g1.z, g1.w};
#pragma unroll
            for (int j = 0; j < 4; ++j) { d[(2 * j) * (AT_VSTR / 2)] = (unsigned short)(w0[j] & 0xffffu); d[(2 * j + 1) * (AT_VSTR / 2)] = (unsigned short)(w0[j] >> 16);
                d[(32 + 2 * j) * (AT_VSTR / 2)] = (unsigned short)(w1[j] & 0xffffu); d[(32 + 2 * j + 1) * (AT_VSTR / 2)] = (unsigned short)(w1[j] >> 16);
                if (j & 1) asm volatile("s_waitcnt lgkmcnt(0)" ::: "memory"); }
        } };
    LAS unsigned* flags = (LAS unsigned*)(lds + AT_FLAG);
    SR RA, RB;
    stage_load(kt_first, RA); stage_store(0, RA);
    stage_load(kt_first - 1, RA);
    __syncthreads();
    auto compute = [&](int kt, int buf) {
        if (!wdone) {
#pragma unroll
            for (int sub = 1; sub >= 0; --sub) {
                const int k0 = 64 * kt + 32 * sub;
                if (k0 <= n0) {
                    const bool diag = (k0 == n0);
                    const LAS unsigned char* kb = lds + AT_KS + buf * 64 * AT_KSTR + (32 * sub + r) * AT_KSTR + 16 * h;
                    f32x16 st;
#pragma unroll
                    for (int i = 0; i < 16; ++i) st[i] = 0.f;
#pragma unroll
                    for (int s = 0; s < 4; ++s) { const s16x8 kf = *(const LAS s16x8*)(kb + 32 * s); st = __builtin_amdgcn_mfma_f32_32x32x16_bf16(kf, qf[s], st, 0, 0, 0); }
                    float w[16];
                    if (MODE == 0) {
                        float sp[16];
#pragma unroll
                        for (int i = 0; i < 16; ++i) { const float z = st[i]; const float t = __builtin_amdgcn_exp2f(-fabsf(z)); sp[i] = __builtin_fmaf(0.5f, z, __builtin_fmaf(0.5f, fabsf(z), __builtin_amdgcn_logf(1.0f + t))); }
                        if (diag) {
#pragma unroll
                            for (int i = 0; i < 16; ++i) if (!(crow(i, h) < r)) sp[i] = 0.f; }
                        const float z0 = st[0];
                        f32x16 af = st;
#pragma unroll
                        for (int s = 0; s < 2; ++s) { h16x8 lf;
#pragma unroll
                            for (int j = 0; j < 8; ++j) lf[j] = (_Float16)(-sp[8 * s + j]);
                            af = __builtin_amdgcn_mfma_f32_32x32x16_f16(uf[s], lf, af, 0, 0, 0); }
#pragma unroll
                        for (int i = 0; i < 16; ++i) w[i] = __builtin_amdgcn_exp2f(af[i] + carry);
                        if (diag) {
#pragma unroll
                            for (int i = 0; i < 16; ++i) if (!(crow(i, h) < r)) w[i] = 0.f; }
                        const float c0 = af[0] - z0; const float cp = __shfl_xor(c0, 32); carry += h ? cp : c0;
                    } else {
                        const float ts = exp2f(lg * (float)(n0 - k0));
#pragma unroll
                        for (int i = 0; i < 16; ++i) w[i] = st[i] * (dl[i] * ts);
                        if (diag) {
#pragma unroll
                            for (int i = 0; i < 16; ++i) if (!(crow(i, h) <= r)) w[i] = 0.f; }
                    }
                    s16x8 pf[2];
#pragma unroll
                    for (int s = 0; s < 2; ++s) { v4u pw; pw.x = cvtpk_bf16(w[8 * s], w[8 * s + 1]); pw.y = cvtpk_bf16(w[8 * s + 2], w[8 * s + 3]); pw.z = cvtpk_bf16(w[8 * s + 4], w[8 * s + 5]); pw.w = cvtpk_bf16(w[8 * s + 6], w[8 * s + 7]); pf[s] = __builtin_bit_cast(s16x8, pw); }
                    const LAS unsigned char* vb = lds + AT_VS + buf * 64 * AT_VSTR + r * AT_VSTR + (32 * sub + 4 * h) * 2;
#pragma unroll
                    for (int s = 0; s < 2; ++s) {
                        const s16x4 a0 = *(const LAS s16x4*)(vb + 32 * s), a1 = *(const LAS s16x4*)(vb + 32 * s + 16);
                        const s16x4 b0 = *(const LAS s16x4*)(vb + 32 * AT_VSTR + 32 * s), b1 = *(const LAS s16x4*)(vb + 32 * AT_VSTR + 32 * s + 16);
                        const s16x8 v0 = __builtin_shufflevector(a0, a1, 0, 1, 2, 3, 4, 5, 6, 7), v1 = __builtin_shufflevector(b0, b1, 0, 1, 2, 3, 4, 5, 6, 7);
                        o0 = __builtin_amdgcn_mfma_f32_32x32x16_bf16(v0, pf[s], o0, 0, 0, 0); o1 = __builtin_amdgcn_mfma_f32_32x32x16_bf16(v1, pf[s], o1, 0, 0, 0); }
                }
            }
            if (MODE == 0 && __all(carry < -152.0f)) wdone = true;
        }
    };
    auto post = [&](int par) { if (MODE == 0 && lane == 0) flags[8 * par + wave] = wdone ? 1u : 0u; };
    auto all_done = [&](int par) -> bool { if (MODE != 0) return false; const v4u f0 = *(const LAS v4u*)(flags + 8 * par), f1 = *(const LAS v4u*)(flags + 8 * par + 4); return (f0.x & f0.y & f0.z & f0.w & f1.x & f1.y & f1.z & f1.w) != 0u; };
#define LBAR() do { asm volatile("s_waitcnt lgkmcnt(0)" ::: "memory"); __builtin_amdgcn_s_barrier(); asm volatile("" ::: "memory"); } while (0)
    for (int kt = kt_first; kt >= kt_lo + 1; kt -= 2) {
        if (kt - 2 >= kt_lo) stage_load(kt - 2, RB);
        compute(kt, 0);
        stage_store(1, RA);
        post(0);
        LBAR();
        if (all_done(0)) break;
        if (kt - 3 >= kt_lo) stage_load(kt - 3, RA);
        compute(kt - 1, 1);
        if (kt - 2 >= kt_lo) stage_store(0, RB);
        post(1);
        LBAR();
        if (all_done(1)) break;
    }
#undef LBAR
    bf16* yo = Y + (rowb + n0 + r) * DM + YCOL + hd * 64;
    if (MODE == 0) {
#pragma unroll
        for (int g = 0; g < 4; ++g) { v2u a; a.x = cvtpk_bf16(o0[4 * g], o0[4 * g + 1]); a.y = cvtpk_bf16(o0[4 * g + 2], o0[4 * g + 3]); *(v2u*)(yo + 8 * g + 4 * h) = a;
            v2u c; c.x = cvtpk_bf16(o1[4 * g], o1[4 * g + 1]); c.y = cvtpk_bf16(o1[4 * g + 2], o1[4 * g + 3]); *(v2u*)(yo + 32 + 8 * g + 4 * h) = c; }
    } else {
        float s = 0.f;
#pragma unroll
        for (int i = 0; i < 16; ++i) s += o0[i] + o1[i];
        s += __shfl_xor(s, 32); const float mu = s * (1.0f / 64.0f); float q2 = 0.f;
#pragma unroll
        for (int i = 0; i < 16; ++i) { const float e0 = o0[i] - mu, e1 = o1[i] - mu; q2 += e0 * e0 + e1 * e1; }
        q2 += __shfl_xor(q2, 32); const float rs = 1.0f / sqrtf(q2 * (1.0f / 64.0f) + 1e-6f);
        const bf16* gp = PROJ + (rowb + n0 + r) * INC + O_RET + 768 + hd * 64;
#pragma unroll
        for (int g = 0; g < 4; ++g)
#pragma unroll
            for (int db = 0; db < 2; ++db) { const int d = 32 * db + 8 * g + 4 * h; const v2u gv = *(const v2u*)(gp + d); const f32x4 gn = *(const f32x4*)(gain + hd * 64 + d);
                const float gg[4] = {bflo(gv.x), bfhi(gv.x), bflo(gv.y), bfhi(gv.y)}; float ov[4];
#pragma unroll
                for (int j = 0; j < 4; ++j) { const float x = db ? o1[4 * g + j] : o0[4 * g + j]; ov[j] = (x - mu) * rs * gn[j] * (gg[j] * __builtin_amdgcn_rcpf(1.0f + __expf(-gg[j]))); }
                v2u a; a.x = cvtpk_bf16(ov[0], ov[1]); a.y = cvtpk_bf16(ov[2], ov[3]); *(v2u*)(yo + d) = a; }
    }
    __syncthreads();
}

__device__ __forceinline__ void ret_state_unit(const bf16* PROJ, const float* ROPE, float* SLOC, unsigned* ctrA, int bh, int qb, LAS unsigned char* lds, int wave, int lane, int tid) {
    const int b = bh >> 2, hd = bh & 3, r = lane & 31, h = lane >> 5; const size_t rowb = (size_t)b * SEQ;
    const int st_row = (tid & 255) >> 2, st_c = tid & 3; const bool st_k = tid < 256;
    const float lg = log2f(1.0f - exp2f(-5.0f - (float)hd));
    v4u g0[4], g1[4]; f32x4 rp4[4][4];
#pragma unroll
    for (int t = 0; t < 4; ++t) { const int key = 256 * qb + 64 * t + st_row; const bf16* src = PROJ + (rowb + key) * INC + O_RET + (st_k ? 256 : 512) + hd * 64 + 8 * st_c; g0[t] = *(const v4u*)src; g1[t] = *(const v4u*)(src + 32);
        if (st_k) { const f32x4* rq = (const f32x4*)(ROPE + (size_t)key * 64 + 16 * st_c);
#pragma unroll
            for (int j = 0; j < 4; ++j) rp4[t][j] = rq[j]; } }
#pragma unroll
    for (int t = 0; t < 4; ++t) { const int jl = 64 * t + st_row;
        float a[8], c2[8]; unpack8(g0[t], a); unpack8(g1[t], c2);
        if (st_k) { const float zeta = exp2f(lg * (float)(255 - jl));
#pragma unroll
            for (int j = 0; j < 8; ++j) { const float cs = rp4[t][j >> 1][2 * (j & 1)], sn = rp4[t][j >> 1][2 * (j & 1) + 1]; const float x1 = a[j], x2 = c2[j]; a[j] = (x1 * cs - x2 * sn) * zeta; c2[j] = (x1 * sn + x2 * cs) * zeta; } }
        LAS unsigned short* d = (LAS unsigned short*)(lds + (st_k ? RS_KT : RS_VT) + (8 * st_c) * RS_STR + 2 * jl);
#pragma unroll
        for (int j = 0; j < 8; j += 2) { const unsigned p0 = cvtpk_bf16(a[j], a[j + 1]), p1 = cvtpk_bf16(c2[j], c2[j + 1]);
            d[j * (RS_STR / 2)] = (unsigned short)(p0 & 0xffffu); d[(j + 1) * (RS_STR / 2)] = (unsigned short)(p0 >> 16);
            d[(32 + j) * (RS_STR / 2)] = (unsigned short)(p1 & 0xffffu); d[(32 + j + 1) * (RS_STR / 2)] = (unsigned short)(p1 >> 16);
            if (j & 2) asm volatile("s_waitcnt lgkmcnt(0)" ::: "memory"); } }
    __syncthreads();
    if (wave < 4) { const int ba = wave >> 1, bb = wave & 1;
        f32x16 acc;
#pragma unroll
        for (int i = 0; i < 16; ++i) acc[i] = 0.f;
        const LAS unsigned char* va = lds + RS_VT + (32 * ba + r) * RS_STR + 16 * h; const LAS unsigned char* ka = lds + RS_KT + (32 * bb + r) * RS_STR + 16 * h;
#pragma unroll
        for (int s = 0; s < 16; ++s) { const s16x4 v0 = *(const LAS s16x4*)(va + 32 * s), v1 = *(const LAS s16x4*)(va + 32 * s + 8), k0 = *(const LAS s16x4*)(ka + 32 * s), k1 = *(const LAS s16x4*)(ka + 32 * s + 8);
            acc = __builtin_amdgcn_mfma_f32_32x32x16_bf16(__builtin_shufflevector(v0, v1, 0, 1, 2, 3, 4, 5, 6, 7), __builtin_shufflevector(k0, k1, 0, 1, 2, 3, 4, 5, 6, 7), acc, 0, 0, 0); }
        float* dst = SLOC + (size_t)(bh * 7 + qb) * 4096 + 32 * bb + r;
#pragma unroll
        for (int i = 0; i < 16; ++i) dst[(size_t)(32 * ba + crow(i, h)) * 64] = acc[i];
    }
    asm volatile("s_waitcnt vmcnt(0)" ::: "memory");
    __syncthreads();
    if (tid == 0) { __builtin_amdgcn_fence(__ATOMIC_RELEASE, "agent"); asm volatile("s_waitcnt vmcnt(0)" ::: "memory"); __hip_atomic_fetch_add(ctrA, 1u, __ATOMIC_RELAXED, __HIP_MEMORY_SCOPE_AGENT); }
    __syncthreads();
}


constexpr int S5_BUSTR = 132 * 4, S5_XSTR = 272, S5_WAVE = 16 * S5_BUSTR + 16 * S5_XSTR, S5_E = 8 * S5_WAVE;
__device__ __forceinline__ void s5_unit(KP p, int l, const bf16* PROJ, bf16* GBo, int bg, LAS unsigned char* lds, int wave, int lane) {
    const int b = bg >> 4, g = bg & 15, lq = lane >> 4, lr = lane & 15; const size_t rowb = (size_t)b * SEQ;
    const int gq = (l * 16 + g) * 64;
    const float dt = expf(((const float*)(GAS const float*)p->in[11])[l * 16 + g]);
    float are, aim;
    { const float lre = ((const float*)(GAS const float*)p->in[4])[gq + lane], lim = ((const float*)(GAS const float*)p->in[5])[gq + lane]; const float mag = expf(lre * dt); are = mag * cosf(lim * dt); aim = mag * sinf(lim * dt); }
    float pr = are, pi = aim;
#pragma unroll
    for (int k = 0; k < 8; ++k) { const float nr = pr * pr - pi * pi, ni = 2.0f * pr * pi; pr = nr; pi = ni; }
    s16x8 bbf[8];
#pragma unroll
    for (int q4 = 0; q4 < 4; ++q4) { const int pp = 16 * q4 + lr; const float lre = ((const float*)(GAS const float*)p->in[4])[gq + pp], lim = ((const float*)(GAS const float*)p->in[5])[gq + pp]; const float mag = expf(lre * dt), ar = mag * cosf(lim * dt), ai = mag * sinf(lim * dt);
        const float den = lre * lre + lim * lim, nr = ar - 1.0f, zre = (nr * lre + ai * lim) / den, zim = (ai * lre - nr * lim) / den;
        const float msk = lq < 2 ? 1.0f : 0.0f; const int hb = 8 * (lq & 1);
        const f32x4 r0 = *(const f32x4*)(((const float*)(GAS const float*)p->in[6]) + (size_t)(gq + pp) * 16 + hb), r1 = *(const f32x4*)(((const float*)(GAS const float*)p->in[6]) + (size_t)(gq + pp) * 16 + hb + 4);
        const f32x4 i0 = *(const f32x4*)(((const float*)(GAS const float*)p->in[7]) + (size_t)(gq + pp) * 16 + hb), i1 = *(const f32x4*)(((const float*)(GAS const float*)p->in[7]) + (size_t)(gq + pp) * 16 + hb + 4);
        float br[8] = {r0[0], r0[1], r0[2], r0[3], r1[0], r1[1], r1[2], r1[3]}, bi[8] = {i0[0], i0[1], i0[2], i0[3], i1[0], i1[1], i1[2], i1[3]}; float vr[8], vi[8];
#pragma unroll
        for (int j = 0; j < 8; ++j) { vr[j] = (zre * br[j] - zim * bi[j]) * msk; vi[j] = (zre * bi[j] + zim * br[j]) * msk; }
        v4u wr_, wi_; wr_.x = cvtpk_bf16(vr[0], vr[1]); wr_.y = cvtpk_bf16(vr[2], vr[3]); wr_.z = cvtpk_bf16(vr[4], vr[5]); wr_.w = cvtpk_bf16(vr[6], vr[7]);
        wi_.x = cvtpk_bf16(vi[0], vi[1]); wi_.y = cvtpk_bf16(vi[2], vi[3]); wi_.z = cvtpk_bf16(vi[4], vi[5]); wi_.w = cvtpk_bf16(vi[6], vi[7]);
        bbf[q4] = __builtin_bit_cast(s16x8, wr_); bbf[q4 + 4] = __builtin_bit_cast(s16x8, wi_); }
    s16x8 cf[4];
#pragma unroll
    for (int s = 0; s < 4; ++s) { const size_t co = ((size_t)(l * 16 + g) * 16 + lr) * 64 + 16 * s + 4 * lq;
        const f32x4 cr = *(const f32x4*)(((const float*)(GAS const float*)p->in[8]) + co), ci = *(const f32x4*)(((const float*)(GAS const float*)p->in[9]) + co);
        v4u w; w.x = cvtpk_bf16(cr[0], -ci[0]); w.y = cvtpk_bf16(cr[1], -ci[1]); w.z = cvtpk_bf16(cr[2], -ci[2]); w.w = cvtpk_bf16(cr[3], -ci[3]); cf[s] = __builtin_bit_cast(s16x8, w); }
    s16x8 dfrag;
    { const float dsk = ((const float*)(GAS const float*)p->in[10])[l * 256 + g * 16 + lr]; const unsigned short db = (unsigned short)f2bf(dsk);
#pragma unroll
      for (int j = 0; j < 8; ++j) dfrag[j] = (lq < 2 && 8 * lq + j == lr) ? (short)db : (short)0; }
    const bf16* usrc = PROJ + (rowb + 256 * wave + lr) * INC + g * 16 + 8 * (lq & 1);
    LAS float* BU = (LAS float*)(lds + wave * S5_WAVE); LAS unsigned char* XB = lds + wave * S5_WAVE + 16 * S5_BUSTR; LAS float* EB = (LAS float*)(lds + S5_E);
    const __amdgpu_buffer_rsrc_t gbrs = __builtin_amdgcn_make_buffer_rsrc((void*)GBo, 0, 0x7fffffff, 0x00020000);
    LAS unsigned char* SG = lds + (wave < 6 ? S5_E + 4096 + 4096 * wave : TAB_OFF + 4096 * (wave - 6));
    float xr = 0.f, xi = 0.f;
#define S5_LW() asm volatile("s_waitcnt lgkmcnt(0)" ::: "memory")
#define S5_TILE_HEAD() \
            v4u uw = uq0; uq0 = uq1; { const int tn = tile + 2 < 16 ? tile + 2 : 15; uq1 = *(const v4u*)(usrc + (size_t)(16 * tn) * INC); } \
            if (lq >= 2) { uw.x = 0u; uw.y = 0u; uw.z = 0u; uw.w = 0u; } \
            const s16x8 uf = __builtin_bit_cast(s16x8, uw); \
            _Pragma("unroll") for (int cb = 0; cb < 8; ++cb) { f32x4 acc = {0.f, 0.f, 0.f, 0.f}; acc = __builtin_amdgcn_mfma_f32_16x16x32_bf16(uf, bbf[cb], acc, 0, 0, 0); \
                _Pragma("unroll") for (int rg = 0; rg < 4; ++rg) BU[(4 * lq + rg) * 132 + 16 * cb + lr] = acc[rg]; \
                if ((cb & 3) == 3) S5_LW(); } \
            float bur[16], bui[16]; \
            _Pragma("unroll") for (int tt = 0; tt < 16; ++tt) { bur[tt] = BU[tt * 132 + lane]; bui[tt] = BU[tt * 132 + 64 + lane]; if ((tt & 7) == 7) S5_LW(); }
    { v4u uq0 = *(const v4u*)usrc, uq1 = *(const v4u*)(usrc + (size_t)16 * INC);
#pragma unroll 1
      for (int tile = 0; tile < 16; ++tile) {
            S5_TILE_HEAD()
#pragma unroll
            for (int tt = 0; tt < 16; ++tt) { const float nxr = are * xr - aim * xi + bur[tt], nxi = are * xi + aim * xr + bui[tt]; xr = nxr; xi = nxi; }
      } }
    { EB[wave * 128 + lane] = xr; EB[wave * 128 + 64 + lane] = xi;
      __syncthreads();
      float cr = 0.f, ci = 0.f;
      for (int w2 = 0; w2 < wave; ++w2) { const float er = EB[w2 * 128 + lane], ei = EB[w2 * 128 + 64 + lane]; const float nr = pr * cr - pi * ci + er, ni = pr * ci + pi * cr + ei; cr = nr; ci = ni; }
      xr = cr; xi = ci; }
    { v4u uq0 = *(const v4u*)usrc, uq1 = *(const v4u*)(usrc + (size_t)16 * INC);
#pragma unroll 1
      for (int tile = 0; tile < 16; ++tile) {
            S5_TILE_HEAD()
#pragma unroll
            for (int tt = 0; tt < 16; ++tt) { const float nxr = are * xr - aim * xi + bur[tt], nxi = are * xi + aim * xr + bui[tt]; xr = nxr; xi = nxi;
                *(LAS unsigned*)(XB + tt * S5_XSTR + 4 * lane) = cvtpk_bf16(xr, xi); if ((tt & 7) == 7) S5_LW(); }
            f32x4 ya = {0.f, 0.f, 0.f, 0.f};
#pragma unroll
            for (int s = 0; s < 4; ++s) { const s16x8 xa = *(const LAS s16x8*)(XB + lr * S5_XSTR + (32 * s + 8 * lq) * 2); ya = __builtin_amdgcn_mfma_f32_16x16x32_bf16(xa, cf[s], ya, 0, 0, 0); }
            ya = __builtin_amdgcn_mfma_f32_16x16x32_bf16(uf, dfrag, ya, 0, 0, 0);
#pragma unroll
            for (int rg = 0; rg < 4; ++rg) { const float y = ya[rg];
                const float gl = y * __builtin_amdgcn_rcpf(1.0f + __expf(-1.5957691216057308f * (y + 0.044715f * y * y * y)));
                *(LAS unsigned short*)(SG + (((tile & 7) * 16 + 4 * lq + rg) * 16 + lr) * 2) = (unsigned short)f2bf(gl); }
            if ((tile & 7) == 7) {
#pragma unroll
                for (int j = 0; j < 4; ++j) { const int c = lane + 64 * j, r = c >> 1, hf = c & 1; const v4u v = *(const LAS v4u*)(SG + r * 32 + hf * 16);
                    __builtin_amdgcn_raw_buffer_store_b128(v, gbrs, (int)(((rowb + 256 * wave + 128 * (tile >> 3) + r) * 256 + g * 16 + hf * 8) * 2), 0, 16); }
            }
      } }
#undef S5_TILE_HEAD
#undef S5_LW
    __syncthreads();
}

__global__ void __launch_bounds__(512, 2) mk_fwd(P p_arg) {
    extern __shared__ __attribute__((aligned(16))) unsigned char lds_raw[];
    LAS unsigned char* lds = (LAS unsigned char*)lds_raw;
    const int tid0 = threadIdx.x, G0 = gridDim.x, bid0 = blockIdx.x, wave0 = __builtin_amdgcn_readfirstlane(tid0 >> 6);
    const KP kp0 = (KP)__builtin_amdgcn_kernarg_segment_ptr();
    volatile LAS unsigned* MISC = (volatile LAS unsigned*)(lds + MISC_OFF);
    if (tid0 < 32) MISC[tid0] = 0u;
    __syncthreads();
#if !MK_MULTI
    XcdBarrier bar = xcd_barrier_post((unsigned*)(kp0->ws + WS_CTL), MISC + 8);
#define SEAM(k) do { if (hi > (k) + 1) xcd_barrier(bar); } while (0)
#else
#define SEAM(k) do { } while (0)
#endif
    const int lo = kp0->ph_lo, hi = kp0->ph_hi;
#define IN(k) (lo <= (k) && (k) < hi)
#define GIN(k_) ((const float*)(GAS const float*)p->in[k_])
#define PH_BEGIN KP p = kp0; asm volatile("" : "+s"(p)); GAS unsigned char* ws = (GAS unsigned char*)p->ws; asm volatile("" : "+s"(ws)); \
    int G = G0, bid = bid0, wave = wave0; asm volatile("" : "+s"(G), "+s"(bid), "+s"(wave)); \
    unsigned ones_ = ~0u; asm volatile("" : "+s"(ones_)); const int lane = (int)__builtin_amdgcn_mbcnt_hi(ones_, __builtin_amdgcn_mbcnt_lo(ones_, 0u)), tid = wave * 64 + lane, gw = bid * 8 + wave, NGW = G * 8; (void)tid; (void)gw; (void)NGW;
#define H ((bf16*)(ws + WS_H))
#define SSQ ((float*)(ws + WS_SSQ))
#define ROPE ((const float*)(ws + WS_ROPE))
#define MEMN ((bf16*)(ws + WS_MEMN))
#define KC ((bf16*)(ws + WS_KC))
#define VT ((bf16*)(ws + WS_VT))
#define PROJ ((bf16*)(ws + AR_PROJ))
#define Y ((bf16*)(ws + AR_Y))
#define GB ((bf16*)(ws + AR_G))
#define ZB ((bf16*)(ws + AR_Z))
#define XS ((float*)(ws + AR_XS))
#define QC ((bf16*)(ws + AR_QC))
#define SC ((float*)(ws + AR_SC))
#define PB ((bf16*)(ws + AR_PB))
#define OC ((bf16*)(ws + AR_OC))
#define ACT ((bf16*)(ws + AR_ACT))
#define XG ((bf16*)(ws + AR_XG))
#define ACTG ((bf16*)(ws + AR_ACTG))
#define DG ((bf16*)(ws + AR_DG))
#define CNT ((int*)(ws + WS_MOEI + MI_CNT))
#define EST ((int*)(ws + WS_MOEI + MI_EST))
#define TOPI ((int*)(ws + WS_MOEI + MI_TOPI))
#define TOPG ((float*)(ws + WS_MOEI + MI_TOPG))
#define RSTD ((float*)(ws + WS_MOEI + MI_RSTD))
#define POS ((int*)(ws + WS_MOEI + MI_POS))
#define RSTDG ((float*)(ws + WS_MOEI + MI_RSTDG))

    if (IN(0)) { PH_BEGIN phase_prologue(p, ws, lds, bid, G, gw, NGW, wave, lane, tid); SEAM(0); }
    if (IN(1)) { PH_BEGIN
        { pg8::Gemm g{MEMN, (const bf16*)(ws + WS_WCK), DM, DM, DM}; pg8::Order S; S.init(MROWS / 256, 4 * DM / 256, G, bid); S.plain(DM, DM);
          pg8::EpiBf16 E{KC, 4 * DM}; pg8::gemm_phase<pg8::EpiBf16, pg8::Order, true, true>(lds, g, S, E, wave); }
        { pg8::Gemm g{MEMN, (const bf16*)(ws + WS_WCV), DM, DM, DM}; pg8::Order S; S.init(MROWS / 256, 4 * DM / 256, G, bid); S.plain(DM, DM);
          pg8::EpiBf16 E{VT, 4 * DM}; pg8::gemm_phase<pg8::EpiBf16, pg8::Order, true, true>(lds, g, S, E, wave); }
        SEAM(1);
    }
    for (int l = 0; l < NL; ++l) {
        const int pb = 3 + 16 * l;
        if (IN(pb + 0)) { PH_BEGIN
            { pg8::Gemm g{(const bf16*)(ws + AR_Y), (const bf16*)(ws + WS_Q8IN + (size_t)l * INC * DM), DM / 2, DM / 2, DM / 2}; pg8::Order S; S.init(T / 256, INC / 256, G, bid); S.plain(DM / 2, DM / 2);
              pg8::EpiScaleI8 E{PROJ, INC, (const float*)(ws + WS_MOEI + MI_RSC0), (const float*)(ws + WS_Q8INS) + (size_t)l * INC, (LAS float*)(lds + TAB_OFF)}; pg8::gemm_phase<pg8::EpiScaleI8, pg8::Order, true, true, true>(lds, g, S, E, wave); }
            { const bool up = bid >= G / 2; const int hc = up ? bid - G / 2 : bid, hg = G / 2;
              if (up) { pg8::Gemm g{KC, (const bf16*)(ws + WS_WCQ), 256, 4 * DM, DM}; pg8::Order S; S.init(64, 4, hg, hc); S.mode = 1; S.lyr = l;
                  pg8::EpiBf16 E{(bf16*)(ws + WS_WK), DM}; pg8::gemm_phase<pg8::EpiBf16, pg8::Order, true, true>(lds, g, S, E, wave); }
              { pg8::Gemm g{(const bf16*)(ws + WS_WCO), VT, 256, DM, 4 * DM}; pg8::Order S; S.init(64, 4, hg, hc); S.mode = 2; S.lyr = l; if (up) S.uend = 128; else S.u0 = 128;
                  pg8::EpiBf16 E{(bf16*)(ws + WS_VO), DM}; pg8::gemm_phase<pg8::EpiBf16, pg8::Order, true, true>(lds, g, S, E, wave); } }
            SEAM(pb + 0);
        }
        if (IN(pb + 1)) { PH_BEGIN
            unsigned* ctr = (unsigned*)(ws + WS_CTL + 16384 + 256 * l); unsigned* ctrA = (unsigned*)(ws + WS_CTL + 24576 + 256 * l); float* SLOC = (float*)(ws + AR_XS);
            for (;;) {
                __syncthreads();
                if (tid == 0) *(LAS unsigned*)(lds + AT_UNIT) = __hip_atomic_fetch_add(ctr, 1u, __ATOMIC_RELAXED, __HIP_MEMORY_SCOPE_AGENT);
                __syncthreads();
                const int u = __builtin_amdgcn_readfirstlane(*(LAS unsigned*)(lds + AT_UNIT));
                if (u >= 448 + 256 + 1024 + 512) break;
                int lane_u = lane; asm volatile("" : "+v"(lane_u)); const int tid_u = wave * 64 + lane_u;
                if (u < 448) ret_state_unit(PROJ, ROPE, SLOC, ctrA, u / 7, u % 7, lds, wave, lane_u, tid_u);
                else if (u < 704) s5_unit(p, l, PROJ, GB, u - 448, lds, wave, lane_u);
                else if (u < 1728) { const int v = u - 704; attn_unit<0>(PROJ, Y, ROPE, nullptr, nullptr, nullptr, v & 127, 7 - (v >> 7), lds, wave, lane_u, tid_u); }
                else { const int v = u - 1728; attn_unit<1>(PROJ, Y, ROPE, GIN(13) + l * DM + 256, SLOC, ctrA, v & 63, 7 - (v >> 6), lds, wave, lane_u, tid_u); }
            }
            SEAM(pb + 1);
        }
        if (IN(pb + 3)) { PH_BEGIN
            const float* gain = GIN(13) + l * DM;
            { pg8::Gemm g{GB, (const bf16*)(ws + WS_WGLU) + (size_t)l * 256 * 256, 256, 256, 256}; pg8::Order S; S.init(T / 256, 1, G, bid); S.plain(256, 256);
              pg8::EpiGlu E{GB, Y, DM, gain, (LAS float*)(lds + TAB_OFF)}; pg8::gemm_phase<pg8::EpiGlu, pg8::Order, true, true>(lds, g, S, E, wave); }
            for (int m = gw; m < T; m += NGW) {
                v4u* yp = (v4u*)(Y + (size_t)m * DM + 512) + lane; const v4u yv = *yp; float a[8]; unpack8(yv, a); float s = 0.f;
#pragma unroll
                for (int j = 0; j < 8; ++j) s += a[j] * a[j];
                const float rs = 1.0f / sqrtf(wave_sum(s) * (1.0f / 512.0f) + NORM_EPS); const f32x4 g0 = ((const f32x4*)(gain + 512))[2 * lane], g1 = ((const f32x4*)(gain + 512))[2 * lane + 1];
                v4u o; o.x = pk2(a[0] * rs * g0[0], a[1] * rs * g0[1]); o.y = pk2(a[2] * rs * g0[2], a[3] * rs * g0[3]); o.z = pk2(a[4] * rs * g1[0], a[5] * rs * g1[1]); o.w = pk2(a[6] * rs * g1[2], a[7] * rs * g1[3]); *yp = o; }
            SEAM(pb + 3);
        }
        if (IN(pb + 5)) { PH_BEGIN
            pg8::Gemm g{Y, (const bf16*)(ws + WS_WOUT) + (size_t)l * DM * DM, DM, DM, DM}; pg8::Order S; S.init(T / 256, DM / 256, G, bid); S.plain(DM, DM);
            pg8::EpiRes E{H, SSQ}; pg8::gemm_phase<pg8::EpiRes, pg8::Order, true, true>(lds, g, S, E, wave);
            SEAM(pb + 5);
        }
        if (IN(pb + 6)) { PH_BEGIN
            pg8::Gemm g{H, (const bf16*)(ws + WS_WK), DM, DM, DM}; pg8::Order S; S.init(T / 256, 4, G, bid);
            S.a_pm = 256L * DM * 2; S.b_pn = 256L * DM * 2; S.b_pb = (long)DM * DM * 2;
            pg8::EpiSoftmax E{PB, DM, (LAS float*)(lds + TAB_OFF), SSQ}; pg8::gemm_phase<pg8::EpiSoftmax, pg8::Order, true, true>(lds, g, S, E, wave);
            SEAM(pb + 6);
        }
        if (IN(pb + 7)) { PH_BEGIN
            pg8::Gemm g{PB, (const bf16*)(ws + WS_VO), DM, DM, DM}; pg8::Order S; S.init(T / 256, 4, G, bid);
            S.a_pm = 256L * DM * 2; S.b_pn = 256L * DM * 2; S.b_pb = (long)DM * DM * 2;
            pg8::EpiRes E{H, SSQ}; pg8::gemm_phase<pg8::EpiRes, pg8::Order, true, true>(lds, g, S, E, wave);
            SEAM(pb + 7);
        }
        if ((l & 1) == 0) {
            if (IN(pb + 8)) { PH_BEGIN
                unsigned char* HQ = (unsigned char*)(ws + AR_Y);
                for (int m = gw; m < T; m += NGW) { float a[8], b2[8]; unpack8(((const v4u*)(H + (size_t)m * DM))[lane], a); unpack8(((const v4u*)(H + (size_t)m * DM + 512))[lane], b2);
                    const float mx = absmax16(a, b2), step = mx > 0.f ? mx * (1.0f / 127.0f) : 1.0f, inv = 1.0f / step;
                    ((v2u*)(HQ + (size_t)m * DM))[lane] = q8_pack8(a, inv); ((v2u*)(HQ + (size_t)m * DM + 512))[lane] = q8_pack8(b2, inv);
                    if (lane == 0) RSTD[m] = step * rstd16(SSQ, m); }
                SEAM(pb + 8);
            }
            if (IN(pb + 11)) { PH_BEGIN
                pg8::Gemm g{(const bf16*)(ws + AR_Y), (const bf16*)(ws + WS_Q8W + (size_t)(l >> 1) * 2 * FF * DM), DM / 2, DM / 2, DM / 2}; pg8::Order S; S.init(T / 256, 2 * FF / 256, G, bid); S.plain(DM / 2, DM / 2);
                pg8::EpiSwigluI8 E{ACT, FF, RSTD, (const float*)(ws + WS_Q8S) + (size_t)(l >> 1) * 2 * FF, 0, (LAS float*)(lds + TAB_OFF)}; pg8::gemm_phase<pg8::EpiSwigluI8, pg8::Order, true, true, true>(lds, g, S, E, wave);
                SEAM(pb + 11);
            }
            if (IN(pb + 12)) { PH_BEGIN
                pg8::Gemm g{ACT, (const bf16*)(ws + WS_WDDN) + (size_t)(l >> 1) * DM * FF, FF, FF, FF}; pg8::Order S; S.init(T / 256, DM / 256, G, bid); S.plain(FF, FF);
                pg8::EpiRes E{H, SSQ}; pg8::gemm_phase<pg8::EpiRes, pg8::Order, true, true>(lds, g, S, E, wave);
                SEAM(pb + 12);
            }
            if (IN(pb + 13)) { PH_BEGIN
                unsigned char* HQ = (unsigned char*)(ws + AR_Y); float* RSC0 = (float*)(ws + WS_MOEI + MI_RSC0);
                for (int m = gw; m < T; m += NGW) { float a[8], b2[8]; unpack8(((const v4u*)(H + (size_t)m * DM))[lane], a); unpack8(((const v4u*)(H + (size_t)m * DM + 512))[lane], b2);
                    const float mx = absmax16(a, b2), step = mx > 0.f ? mx * (1.0f / 127.0f) : 1.0f, inv = 1.0f / step;
                    ((v2u*)(HQ + (size_t)m * DM))[lane] = q8_pack8(a, inv); ((v2u*)(HQ + (size_t)m * DM + 512))[lane] = q8_pack8(b2, inv);
                    if (lane == 0) RSC0[m] = step * rstd16(SSQ, m); }
                SEAM(pb + 13);
            }
        } else {
            if (IN(pb + 11)) { PH_BEGIN
                LAS int* hist = (LAS int*)lds; LAS float* lgs = (LAS float*)(lds + 64) + wave * 128; if (tid < 8) hist[tid] = 0; __syncthreads();
                const float* WRl = (const float*)(ws + WS_WR) + (size_t)(l >> 1) * DM * NEXP;
                const int tok0 = bid * 128 + wave * 16, lr = lane & 15, lq = lane >> 4;
                f32x4 acc = {0.f, 0.f, 0.f, 0.f};
                const bf16* hp = H + (size_t)(tok0 + lr) * DM + 8 * lq; const float* wp = WRl + (size_t)(8 * lq) * 8 + (lr & 7); const float bm = lr < 8 ? 1.0f : 0.0f;
#pragma unroll 2
                for (int s2 = 0; s2 < 32; ++s2) { float a[8]; unpack8(*(const v4u*)(hp + 32 * s2), a);
#pragma unroll
                    for (int j = 0; j < 8; ++j) acc = __builtin_amdgcn_mfma_f32_16x16x4f32(a[j], wp[(size_t)(32 * s2 + j) * 8] * bm, acc, 0, 0, 0); }
                if (lr < 8) {
#pragma unroll
                    for (int rg = 0; rg < 4; ++rg) lgs[(4 * lq + rg) * 8 + lr] = acc[rg]; }
                asm volatile("s_waitcnt lgkmcnt(0)" ::: "memory");
                if (lane < 16) { const int row = tok0 + lane; const float rs = rstd16(SSQ, row); const f32x4 l0 = *(const LAS f32x4*)(lgs + lane * 8), l1 = *(const LAS f32x4*)(lgs + lane * 8 + 4);
                    const float lg[8] = {l0[0] * rs, l0[1] * rs, l0[2] * rs, l0[3] * rs, l1[0] * rs, l1[1] * rs, l1[2] * rs, l1[3] * rs};
                    float v1 = lg[0]; int i1 = 0;
#pragma unroll
                    for (int e = 1; e < 8; ++e) if (lg[e] > v1) { v1 = lg[e]; i1 = e; }
                    float v2 = -3.0e38f; int i2 = -1;
#pragma unroll
                    for (int e = 0; e < 8; ++e) if (e != i1 && lg[e] > v2) { v2 = lg[e]; i2 = e; }
                    const float g2 = 1.0f / (1.0f + expf(v1 - v2)), g1 = 1.0f - g2;
                    TOPI[2 * row] = i1; TOPI[2 * row + 1] = i2; TOPG[2 * row] = g1; TOPG[2 * row + 1] = g2; RSTD[row] = rs;
                    __hip_atomic_fetch_add(&hist[i1], 1, __ATOMIC_RELAXED, __HIP_MEMORY_SCOPE_WORKGROUP); __hip_atomic_fetch_add(&hist[i2], 1, __ATOMIC_RELAXED, __HIP_MEMORY_SCOPE_WORKGROUP); }
                __syncthreads(); if (tid < 8) CNT[bid * 8 + tid] = hist[tid];
                SEAM(pb + 11);
            }
            if (IN(pb + 12)) { PH_BEGIN
                unsigned char* XQ = (unsigned char*)(ws + AR_XG);
                LAS int* sh = (LAS int*)lds;
                if (tid < 16) sh[tid] = 0;
                __syncthreads();
                { const int4 c = ((const int4*)CNT)[tid]; const int w = tid >> 1, e0 = 4 * (tid & 1); const int cc[4] = {c.x, c.y, c.z, c.w};
#pragma unroll
                  for (int i = 0; i < 4; ++i) { __hip_atomic_fetch_add(&sh[e0 + i], cc[i], __ATOMIC_RELAXED, __HIP_MEMORY_SCOPE_WORKGROUP); if (w < bid) __hip_atomic_fetch_add(&sh[8 + e0 + i], cc[i], __ATOMIC_RELAXED, __HIP_MEMORY_SCOPE_WORKGROUP); } }
                int myexp = 0; if (tid < 256) { myexp = TOPI[(size_t)bid * 256 + tid]; sh[320 + tid] = myexp; }
                __syncthreads();
                if (tid == 0) { int s = 0; for (int e = 0; e < 8; ++e) { sh[16 + e] = s; sh[32 + e] = s + sh[8 + e]; s += (sh[e] + 255) & ~255; } sh[24] = s;
                    if (bid == 0) for (int e = 0; e < 9; ++e) EST[e] = sh[16 + e]; }
                int rank = 0;
                if (tid < 256) {
#pragma unroll
                    for (int e = 0; e < 8; ++e) { const unsigned long long m = __builtin_amdgcn_ballot_w64(myexp == e); if (myexp == e) rank = __builtin_popcountll(m & ((1ull << lane) - 1ull)); if (lane == 0) sh[576 + wave * 8 + e] = __builtin_popcountll(m); } }
                __syncthreads();
                if (tid < 256) { int pos = sh[32 + myexp] + rank; for (int w2 = 0; w2 < wave; ++w2) pos += sh[576 + w2 * 8 + myexp]; sh[64 + tid] = pos; }
                __syncthreads();
#pragma unroll 1
                for (int k4 = 0; k4 < 4; ++k4) { v4u a[4], b2[4]; float rs[4];
#pragma unroll
                    for (int q = 0; q < 4; ++q) { const int row = bid * 128 + wave * 16 + 4 * k4 + q; a[q] = ((const v4u*)(H + (size_t)row * DM))[lane]; b2[q] = ((const v4u*)(H + (size_t)row * DM + 512))[lane]; rs[q] = RSTD[row]; }
#pragma unroll
                    for (int q = 0; q < 4; ++q) { const int k = wave * 16 + 4 * k4 + q, row = bid * 128 + k;
                        float fa[8], fb[8]; unpack8(a[q], fa); unpack8(b2[q], fb);
                        const float mx = absmax16(fa, fb), step = mx > 0.f ? mx * (1.0f / 127.0f) : 1.0f, inv = 1.0f / step; const v2u qa = q8_pack8(fa, inv), qb = q8_pack8(fb, inv);
#pragma unroll
                        for (int sl = 0; sl < 2; ++sl) { const int pos = sh[64 + 2 * k + sl]; ((v2u*)(XQ + (size_t)pos * DM))[lane] = qa; ((v2u*)(XQ + (size_t)pos * DM + 512))[lane] = qb;
                            if (lane == 0) { RSTDG[pos] = rs[q] * step; POS[2 * row + sl] = pos; } } } }
                { const int e = bid & 7, i = (bid >> 3) * 8 + wave, pos = sh[16 + e] + sh[e] + i;
                  if (pos < sh[16 + e + 1]) { unsigned zz = 0u; asm volatile("" : "+v"(zz)); const v4u z = {zz, zz, zz, zz}; ((v4u*)(XQ + (size_t)pos * DM))[lane] = z; if (lane == 0) RSTDG[pos] = 0.f; } }
                SEAM(pb + 12);
            }
            if (IN(pb + 13)) { PH_BEGIN
                const int nM = __builtin_amdgcn_readfirstlane(EST[8]) / 256;
                pg8::Gemm g{(const bf16*)(ws + AR_XG), (const bf16*)(ws + WS_Q8W + (size_t)(2 + (l >> 1) * NEXP) * 2 * FF * DM), DM / 2, DM / 2, DM / 2}; pg8::Order S; S.init(nM, 2 * FF / 256, G, bid); S.plain(DM / 2, DM / 2);
                S.estart = EST; S.b_e = (long)2 * FF * DM;
                pg8::EpiSwigluI8 E{ACTG, FF, RSTDG, (const float*)(ws + WS_Q8S) + (size_t)(2 + (l >> 1) * NEXP) * 2 * FF, 2 * FF, (LAS float*)(lds + TAB_OFF)}; pg8::gemm_phase<pg8::EpiSwigluI8, pg8::Order, true, true, true>(lds, g, S, E, wave);
                SEAM(pb + 13);
            }
            if (IN(pb + 14)) { PH_BEGIN
                const int nM = __builtin_amdgcn_readfirstlane(EST[8]) / 256, nMain = nM < 256 ? nM : 256, nOv = nM - nMain;
                { pg8::Gemm g{ACTG, (const bf16*)(ws + WS_WEDN) + (size_t)(l >> 1) * NEXP * DM * FF, FF, FF, FF}; pg8::Order S; S.init(nMain, DM / 256, G, bid); S.plain(FF, FF);
                  S.estart = EST; S.b_e = (long)DM * FF * 2;
                  pg8::EpiBf16 E{DG, DM}; pg8::gemm_phase<pg8::EpiBf16, pg8::Order, true, true>(lds, g, S, E, wave); }
                if (nOv > 0) { pg8::Gemm g{ACTG, (const bf16*)(ws + WS_WEDN) + (size_t)(l >> 1) * NEXP * DM * FF, 256, FF, FF}; pg8::Order S; S.init(nOv * 11, DM / 256, G, bid); S.mode = 3; S.estart = EST;
                  pg8::EpiF32 E{(float*)(ws + AR_XG), DM}; pg8::gemm_phase<pg8::EpiF32, pg8::Order, true, true>(lds, g, S, E, wave); }
                SEAM(pb + 14);
            }
            if (IN(pb + 15)) { PH_BEGIN
                const bool last = (l == NL - 1); const float* fw = GIN(26); float* outp = ((float*)(GAS float*)p->out);
                for (int m = gw; m < T; m += NGW) { const int p0 = POS[2 * m], p1 = POS[2 * m + 1]; const float g0 = TOPG[2 * m], g1 = TOPG[2 * m + 1]; float s = 0.f; float hv[2][8];
#pragma unroll
                    for (int hf = 0; hf < 2; ++hf) { v4u* hp = (v4u*)(H + (size_t)m * DM + 512 * hf) + lane; float a[8], d0[8], d1[8]; unpack8(*hp, a);
                        auto ldrow = [&](int pp, float* d) { if (pp < 65536) { unpack8(((const v4u*)(DG + (size_t)pp * DM + 512 * hf))[lane], d); }
                            else { const int ov = pp - 65536, pmo = ov >> 8, rr = ov & 255; const float* base = (const float*)(ws + AR_XG) + ((size_t)(pmo * 11) * 256 + rr) * DM + 512 * hf + 8 * lane;
#pragma unroll
                                for (int j = 0; j < 8; ++j) d[j] = 0.f;
                                for (int ks = 0; ks < 11; ++ks) { const f32x4 q0 = *(const f32x4*)(base + (size_t)ks * 256 * DM), q1 = *(const f32x4*)(base + (size_t)ks * 256 * DM + 4);
#pragma unroll
                                    for (int j = 0; j < 4; ++j) { d[j] += q0[j]; d[4 + j] += q1[j]; } } } };
                        ldrow(p0, d0); ldrow(p1, d1);
#pragma unroll
                        for (int j = 0; j < 8; ++j) a[j] += g0 * d0[j] + g1 * d1[j];
                        v4u o; o.x = pk2(a[0], a[1]); o.y = pk2(a[2], a[3]); o.z = pk2(a[4], a[5]); o.w = pk2(a[6], a[7]); if (!last) *hp = o;
                        unpack8(o, hv[hf]);
#pragma unroll
                        for (int j = 0; j < 8; ++j) s += hv[hf][j] * hv[hf][j]; }
                    s = wave_sum(s);
                    if (!last) { if (lane < 16) SSQ[(size_t)m * 16 + lane] = lane == 0 ? s : 0.f;
                        float mx = 0.f;
#pragma unroll
                        for (int hf = 0; hf < 2; ++hf)
#pragma unroll
                            for (int j = 0; j < 8; ++j) mx = fmaxf(mx, fabsf(hv[hf][j]));
                        mx = wave_max(mx); const float step = mx > 0.f ? mx * (1.0f / 127.0f) : 1.0f, inv = 1.0f / step;
                        ((v2u*)((unsigned char*)(ws + AR_Y) + (size_t)m * DM))[lane] = q8_pack8(hv[0], inv); ((v2u*)((unsigned char*)(ws + AR_Y) + (size_t)m * DM + 512))[lane] = q8_pack8(hv[1], inv);
                        if (lane == 0) ((float*)(ws + WS_MOEI + MI_RSC0))[m] = step / sqrtf(s * (1.0f / DM) + NORM_EPS); }
                    else { const float rs = 1.0f / sqrtf(s * (1.0f / DM) + NORM_EPS);
#pragma unroll
                        for (int hf = 0; hf < 2; ++hf) { const f32x4 w0 = ((const f32x4*)(fw + 512 * hf))[2 * lane], w1 = ((const f32x4*)(fw + 512 * hf))[2 * lane + 1];
                            f32x4 o0 = {hv[hf][0] * rs * w0[0], hv[hf][1] * rs * w0[1], hv[hf][2] * rs * w0[2], hv[hf][3] * rs * w0[3]}, o1 = {hv[hf][4] * rs * w1[0], hv[hf][5] * rs * w1[1], hv[hf][6] * rs * w1[2], hv[hf][7] * rs * w1[3]};
                            f32x4* op = (f32x4*)(outp + (size_t)m * DM + 512 * hf) + 2 * lane; op[0] = o0; op[1] = o1; } } }
                SEAM(pb + 15);
            }
        }
    }
#undef IN
#undef SEAM
}

extern "C" void kernel_launch(void* const* d_in, const int* in_sizes, int n_in, void* d_out, int out_size, void* d_ws, size_t ws_size, hipStream_t stream) {
    static int grid = 0;
    if (grid == 0) {
        if (n_in != 27 || in_sizes[0] != T * DM || out_size != T * DM || ws_size < WS_END) { fprintf(stderr, "kernel_launch: unexpected problem (n_in %d, in0 %d, out %d, ws %zu < %zu); nothing launched\n", n_in, n_in > 0 ? in_sizes[0] : -1, out_size, ws_size, (size_t)WS_END); grid = -1; return; }
        int dev = 0, cus = 0;
        if (hipGetDevice(&dev) != hipSuccess || hipDeviceGetAttribute(&cus, hipDeviceAttributeMultiprocessorCount, dev) != hipSuccess) { fprintf(stderr, "kernel_launch: device query failed\n"); grid = -1; return; }
        if (hipFuncSetAttribute((const void*)mk_fwd, hipFuncAttributeMaxDynamicSharedMemorySize, LDS_BYTES) != hipSuccess) { fprintf(stderr, "kernel_launch: hipFuncSetAttribute failed\n"); grid = -1; return; }
        int per_cu = 0; (void)hipOccupancyMaxActiveBlocksPerMultiprocessor(&per_cu, (const void*)mk_fwd, 512, LDS_BYTES); (void)hipGetLastError();
        if (cus != 256 || per_cu < 1) { fprintf(stderr, "kernel_launch: needs 256 CUs with one resident workgroup each (cus %d, per_cu %d)\n", cus, per_cu); grid = -1; return; }
        grid = 256;
    }
    if (grid < 0) return;
    (void)hipMemsetAsync((char*)d_ws + WS_CTL, 0, 32768, stream);
    P a{};
    for (int i = 0; i < 27; ++i) a.in[i] = (const float*)d_in[i];
    a.out = (float*)d_out; a.ws = (unsigned char*)d_ws;
    constexpr int NPH = 3 + 16 * NL;
#if MK_MULTI
    for (int ph = 0; ph < NPH; ++ph) {
        if (ph >= 3 && ph < 3 + 16 * NL) { const int l = (ph - 3) / 16, k = (ph - 3) % 16; if ((l & 1) == 0 && k > 13) continue; }
        a.ph_lo = ph; a.ph_hi = ph + 1;
        hipLaunchKernelGGL(mk_fwd, dim3(grid), dim3(512), LDS_BYTES, stream, a);
    }
#else
    a.ph_lo = 0; a.ph_hi = NPH;
    hipLaunchKernelGGL(mk_fwd, dim3(grid), dim3(512), LDS_BYTES, stream, a);
#endif
}
```

```cpp
#include <hip/hip_runtime.h>
#include <cstdio>
#include <cstdint>
#ifndef MK_MULTI
#define MK_MULTI 0
#endif
namespace pg8 {
#define PG8_LAS __attribute__((address_space(3)))
typedef unsigned short bf16_t;
typedef short bf16x8 __attribute__((ext_vector_type(8)));
typedef float f32x4 __attribute__((ext_vector_type(4)));
typedef unsigned u32x4 __attribute__((ext_vector_type(4)));
typedef int i32x4 __attribute__((ext_vector_type(4)));
template <bool I8> struct AccSel { typedef f32x4 T; };
template <> struct AccSel<true> { typedef i32x4 T; };
template <bool I8> __device__ __forceinline__ typename AccSel<I8>::T mma1(bf16x8 b, bf16x8 a, typename AccSel<I8>::T c) {
    if constexpr (I8) return __builtin_amdgcn_mfma_i32_16x16x64_i8(__builtin_bit_cast(i32x4, b), __builtin_bit_cast(i32x4, a), c, 0, 0, 0);
    else return __builtin_amdgcn_mfma_f32_16x16x32_bf16(b, a, c, 0, 0, 0);
}
constexpr int BM = 256, BK = 64, HALF = 128, HTB = HALF * BK * 2  , STAGE_BYTES = 8 * HTB, NXCD = 8, WGM = 8;

__host__ __device__ __forceinline__ int lds_byte(int r, int c) { const int st = (r >> 4) * 2 + (c >> 5), rr = r & 15, cc = c & 31, ob = rr * 64 + cc * 2; return st * 1024 + (ob ^ (((ob >> 9) & 1) << 5)); }
__host__ __device__ __forceinline__ void stage_rc(int b, int& R, int& C) { const int st = b / 1024, sb = b % 1024, swz = sb ^ (((sb >> 9) & 1) << 5); R = (st >> 1) * 16 + swz / 64; C = (st & 1) * 32 + (swz % 64) / 2; }
__host__ __device__ __forceinline__ int perm32(int rho) { const int n = rho >> 4, i = rho & 15; return 8 * (i >> 2) + 4 * n + (i & 3); }

struct Unit { int pm, pn; long aoff, boff; int e; int par; };
struct Gemm { const bf16_t* A; const bf16_t* Bt; int K, lda, ldb; };

struct Order {
    int nM, nN, nwg, G, c, mode, lyr, u0, uend; long a_pm, a_pn, b0, b_pn, b_pb, b_e; const int* estart; int est[8];
    __device__ void init(int nM_, int nN_, int G_, int c_) { nM = nM_; nN = nN_; nwg = nM * nN; G = G_; c = c_; u0 = 0; uend = nwg; mode = 0; lyr = 0; a_pm = 0; a_pn = 0; b0 = 0; b_pn = 0; b_pb = 0; b_e = 0; estart = nullptr; }
    __device__ void plain(int lda, int ldb) { a_pm = 256L * lda * 2; b_pn = 256L * ldb * 2; }
    __device__ void experts(const int* es) { estart = es;
#pragma unroll
        for (int j = 0; j < 8; ++j) est[j] = __builtin_amdgcn_readfirstlane(es[j]); }
    __device__ bool next(int i, Unit& u) const {
        const long L = (long)u0 + (long)i * G + c; if (L >= uend) return false;
        int wgid = (int)L; { const int q = nwg / NXCD, r = nwg % NXCD, xcd = wgid % NXCD, off = wgid / NXCD; wgid = (xcd < r ? xcd * (q + 1) : r * (q + 1) + (xcd - r) * q) + off; }
        const int nig = WGM * nN, gid = wgid / nig, fm = gid * WGM, gsz = (nM - fm) < WGM ? (nM - fm) : WGM;
        u.pm = fm + ((wgid % nig) % gsz); u.pn = (wgid % nig) / gsz;
        long e = 0; if (estart && mode == 0) { const int r0 = u.pm * 256;
#pragma unroll
            for (int j = 1; j < 8; ++j) e += (r0 >= est[j]) ? 1 : 0; }
        if (mode == 1)      { const long l = lyr, b = (u.pm >> 2) & 15, hh = u.pm & 3; u.aoff = ((b * 256) * 4096 + l * 1024 + hh * 256) * 2; u.boff = ((l * 1024 + u.pn * 256) * 1024 + hh * 256) * 2; }
        else if (mode == 2) { const long l = lyr, b = (u.pm >> 2) & 15, nt = u.pm & 3; u.aoff = ((l * 1024 + nt * 256) * 1024 + u.pn * 256) * 2; u.boff = ((b * 256) * 4096 + l * 1024 + u.pn * 256) * 2; }
        else if (mode == 3) { const int pmo = u.pm / 11, ks = u.pm - pmo * 11; const int r0 = (256 + pmo) * 256; long e3 = 0;
#pragma unroll
            for (int j = 1; j < 8; ++j) e3 += (r0 >= est[j]) ? 1 : 0;
            u.aoff = ((long)r0 * 2816 + ks * 256) * 2; u.boff = ((e3 * 1024 + u.pn * 256) * 2816 + ks * 256) * 2; }
        else { u.aoff = u.pm * a_pm + u.pn * a_pn; u.boff = b0 + u.pn * b_pn + (long)(u.pm >> 3) * b_pb + e * b_e; }
        u.e = (int)e; return true;
    }
    __device__ __forceinline__ void a_ready(const Unit&) const {}
    __device__ __forceinline__ void done(const Unit&) const {}
};

__device__ __forceinline__ unsigned cvt_pk_bf16(float lo, float hi) { unsigned r; asm volatile("v_cvt_pk_bf16_f32 %0, %1, %2" : "=v"(r) : "v"(lo), "v"(hi)); return r; }
__device__ __forceinline__ float bflo(unsigned w) { return __uint_as_float(w << 16); }
__device__ __forceinline__ float bfhi(unsigned w) { return __uint_as_float(w & 0xffff0000u); }
__device__ __forceinline__ float rstd16(const float* ssq, int r) {
    const f32x4* p = (const f32x4*)(ssq + (size_t)r * 16); const f32x4 a = p[0], b = p[1], c = p[2], d = p[3];
    const float s = (((a[0] + a[1]) + (a[2] + a[3])) + ((b[0] + b[1]) + (b[2] + b[3]))) + (((c[0] + c[1]) + (c[2] + c[3])) + ((d[0] + d[1]) + (d[2] + d[3])));
    return __builtin_amdgcn_rsqf(s * (1.0f / 1024.0f) + 1e-6f);
}

template <class E> struct EpiPre { static constexpr bool v = false; };
struct EpiF32 {
    static constexpr bool PERM = true, AFTER_DRAIN = false;
    float* C; int ldc;
    __device__ __forceinline__ void operator()(const f32x4 (&acc)[2][2][4][2], const Unit& u, int wr, int wc, int fr, int fq) const {
        const int row0 = u.pm * BM + wr * 64 + fr, col0 = u.pn * BM + wc * 32 + 8 * fq;
#pragma unroll
        for (int ai = 0; ai < 2; ++ai)
#pragma unroll
            for (int m = 0; m < 4; ++m) { float* rowp = C + (size_t)(row0 + ai * HALF + m * 16) * ldc + col0;
#pragma unroll
                for (int bj = 0; bj < 2; ++bj) { *(f32x4*)(rowp + bj * HALF) = acc[ai][bj][m][0]; *(f32x4*)(rowp + bj * HALF + 4) = acc[ai][bj][m][1]; } }
    }
};
struct EpiBf16 {
    static constexpr bool PERM = true, AFTER_DRAIN = false;
    bf16_t* O; int ldc;
    __device__ __forceinline__ void operator()(const f32x4 (&acc)[2][2][4][2], const Unit& u, int wr, int wc, int fr, int fq) const {
        const int row0 = u.pm * BM + wr * 64 + fr, col0 = u.pn * BM + wc * 32 + 8 * fq;
#pragma unroll
        for (int ai = 0; ai < 2; ++ai)
#pragma unroll
            for (int m = 0; m < 4; ++m) { bf16_t* rowp = O + (size_t)(row0 + ai * HALF + m * 16) * ldc + col0;
#pragma unroll
                for (int bj = 0; bj < 2; ++bj) { const f32x4 v0 = acc[ai][bj][m][0], v1 = acc[ai][bj][m][1];
                    u32x4 w; w.x = cvt_pk_bf16(v0[0], v0[1]); w.y = cvt_pk_bf16(v0[2], v0[3]); w.z = cvt_pk_bf16(v1[0], v1[1]); w.w = cvt_pk_bf16(v1[2], v1[3]);
                    *(u32x4*)(rowp + bj * HALF) = w; } }
    }
};
struct EpiScale {
    static constexpr bool PERM = true, AFTER_DRAIN = false;
    bf16_t* O; int ldc; const float* ssq;
    __device__ __forceinline__ void operator()(const f32x4 (&acc)[2][2][4][2], const Unit& u, int wr, int wc, int fr, int fq) const {
        const int row0 = u.pm * BM + wr * 64 + fr, col0 = u.pn * BM + wc * 32 + 8 * fq;
#pragma unroll
        for (int ai = 0; ai < 2; ++ai)
#pragma unroll
            for (int m = 0; m < 4; ++m) { const int r = row0 + ai * HALF + m * 16; const float rs = rstd16(ssq, r); bf16_t* rowp = O + (size_t)r * ldc + col0;
#pragma unroll
                for (int bj = 0; bj < 2; ++bj) { const f32x4 v0 = acc[ai][bj][m][0] * rs, v1 = acc[ai][bj][m][1] * rs;
                    u32x4 w; w.x = cvt_pk_bf16(v0[0], v0[1]); w.y = cvt_pk_bf16(v0[2], v0[3]); w.z = cvt_pk_bf16(v1[0], v1[1]); w.w = cvt_pk_bf16(v1[2], v1[3]);
                    *(u32x4*)(rowp + bj * HALF) = w; } }
    }
};
struct EpiRes {
    static constexpr bool PERM = true, AFTER_DRAIN = false;
    bf16_t* H; float* ssq;
    __device__ __forceinline__ void operator()(const f32x4 (&acc)[2][2][4][2], const Unit& u, int wr, int wc, int fr, int fq) const {
        const int row0 = u.pm * BM + wr * 64 + fr, col0 = u.pn * BM + wc * 32 + 8 * fq;
        u32x4 ov[2][4][2];
#pragma unroll
        for (int ai = 0; ai < 2; ++ai)
#pragma unroll
            for (int m = 0; m < 4; ++m)
#pragma unroll
                for (int bj = 0; bj < 2; ++bj) ov[ai][m][bj] = *(const u32x4*)(H + (size_t)(row0 + ai * HALF + m * 16) * 1024 + col0 + bj * HALF);
#pragma unroll
        for (int ai = 0; ai < 2; ++ai)
#pragma unroll
            for (int m = 0; m < 4; ++m) { const int r = row0 + ai * HALF + m * 16; bf16_t* rowp = H + (size_t)r * 1024 + col0; float s = 0.f;
#pragma unroll
                for (int bj = 0; bj < 2; ++bj) { const u32x4 o = ov[ai][m][bj]; const f32x4 a0 = acc[ai][bj][m][0], a1 = acc[ai][bj][m][1];
                    u32x4 w; w.x = cvt_pk_bf16(a0[0] + bflo(o.x), a0[1] + bfhi(o.x)); w.y = cvt_pk_bf16(a0[2] + bflo(o.y), a0[3] + bfhi(o.y));
                    w.z = cvt_pk_bf16(a1[0] + bflo(o.z), a1[1] + bfhi(o.z)); w.w = cvt_pk_bf16(a1[2] + bflo(o.w), a1[3] + bfhi(o.w));
                    *(u32x4*)(rowp + bj * HALF) = w;
                    s += (bflo(w.x) * bflo(w.x) + bfhi(w.x) * bfhi(w.x)) + (bflo(w.y) * bflo(w.y) + bfhi(w.y) * bfhi(w.y)) + (bflo(w.z) * bflo(w.z) + bfhi(w.z) * bfhi(w.z)) + (bflo(w.w) * bflo(w.w) + bfhi(w.w) * bfhi(w.w)); }
                s += __shfl_xor(s, 16); s += __shfl_xor(s, 32);
                if (fq == 0) ssq[(size_t)r * 16 + u.pn * 4 + wc] = s; }
    }
};
struct EpiSoftmax {
    static constexpr bool PERM = true, AFTER_DRAIN = false;
    bf16_t* O; int ldc; PG8_LAS float* tab; const float* ssq;
    __device__ __forceinline__ void operator()(f32x4 (&acc)[2][2][4][2], const Unit& u, int wr, int wc, int fr, int fq) const {
        const int row0 = u.pm * BM + wr * 64 + fr, col0 = u.pn * BM + wc * 32 + 8 * fq;
#pragma unroll
        for (int ai = 0; ai < 2; ++ai)
#pragma unroll
            for (int m = 0; m < 4; ++m) { float mx = -3.0e38f; const float rs = ssq ? rstd16(ssq, row0 + ai * HALF + m * 16) : 1.0f;
#pragma unroll
                for (int bj = 0; bj < 2; ++bj)
#pragma unroll
                    for (int n = 0; n < 2; ++n) { const f32x4 x = acc[ai][bj][m][n] * rs; acc[ai][bj][m][n] = x; mx = fmaxf(mx, fmaxf(fmaxf(x[0], x[1]), fmaxf(x[2], x[3]))); }
                mx = fmaxf(mx, __shfl_xor(mx, 16)); mx = fmaxf(mx, __shfl_xor(mx, 32));
                if (fq == 0) tab[(ai * HALF + wr * 64 + m * 16 + fr) * 4 + wc] = mx; }
        asm volatile("s_waitcnt lgkmcnt(0)" ::: "memory"); __builtin_amdgcn_s_barrier(); asm volatile("" ::: "memory");
#pragma unroll
        for (int ai = 0; ai < 2; ++ai)
#pragma unroll
            for (int m = 0; m < 4; ++m) { const int rl = ai * HALF + wr * 64 + m * 16 + fr; const f32x4 t = *(const PG8_LAS f32x4*)(tab + rl * 4); const float M = fmaxf(fmaxf(t[0], t[1]), fmaxf(t[2], t[3])); float s = 0.f;
#pragma unroll
                for (int bj = 0; bj < 2; ++bj)
#pragma unroll
                    for (int n = 0; n < 2; ++n) { f32x4 e;
#pragma unroll
                        for (int j = 0; j < 4; ++j) e[j] = __builtin_amdgcn_exp2f(acc[ai][bj][m][n][j] - M);
                        acc[ai][bj][m][n] = e; s += (e[0] + e[1]) + (e[2] + e[3]); }
                s += __shfl_xor(s, 16); s += __shfl_xor(s, 32);
                if (fq == 0) tab[1024 + rl * 4 + wc] = s; }
        asm volatile("s_waitcnt lgkmcnt(0)" ::: "memory"); __builtin_amdgcn_s_barrier(); asm volatile("" ::: "memory");
#pragma unroll
        for (int ai = 0; ai < 2; ++ai)
#pragma unroll
            for (int m = 0; m < 4; ++m) { const int rl = ai * HALF + wr * 64 + m * 16 + fr; const f32x4 t = *(const PG8_LAS f32x4*)(tab + 1024 + rl * 4); const float inv = 1.0f / ((t[0] + t[1]) + (t[2] + t[3]));
                bf16_t* rowp = O + (size_t)(row0 + ai * HALF + m * 16) * ldc + col0;
#pragma unroll
                for (int bj = 0; bj < 2; ++bj) { const f32x4 v0 = acc[ai][bj][m][0] * inv, v1 = acc[ai][bj][m][1] * inv;
                    u32x4 w; w.x = cvt_pk_bf16(v0[0], v0[1]); w.y = cvt_pk_bf16(v0[2], v0[3]); w.z = cvt_pk_bf16(v1[0], v1[1]); w.w = cvt_pk_bf16(v1[2], v1[3]);
                    *(u32x4*)(rowp + bj * HALF) = w; } }
    }
};
struct EpiGlu {
    static constexpr bool PERM = true, AFTER_DRAIN = false;
    const bf16_t* G; bf16_t* O; int ldc; const float* gain; PG8_LAS float* tab;
    __device__ __forceinline__ void operator()(f32x4 (&acc)[2][2][4][2], const Unit& u, int wr, int wc, int fr, int fq) const {
        const int row0 = u.pm * BM + wr * 64 + fr, col0 = wc * 32 + 8 * fq;
#pragma unroll
        for (int ai = 0; ai < 2; ++ai)
#pragma unroll
            for (int m = 0; m < 4; ++m) { const int r = row0 + ai * HALF + m * 16; float s = 0.f;
#pragma unroll
                for (int bj = 0; bj < 2; ++bj) { const u32x4 gv = *(const u32x4*)(G + (size_t)r * 256 + col0 + bj * HALF);
                    const float gg[8] = {bflo(gv.x), bfhi(gv.x), bflo(gv.y), bfhi(gv.y), bflo(gv.z), bfhi(gv.z), bflo(gv.w), bfhi(gv.w)};
#pragma unroll
                    for (int n = 0; n < 2; ++n) { f32x4 a;
#pragma unroll
                        for (int j = 0; j < 4; ++j) { a[j] = gg[4 * n + j] * __builtin_amdgcn_rcpf(1.0f + __expf(-acc[ai][bj][m][n][j])); s += a[j] * a[j]; }
                        acc[ai][bj][m][n] = a; } }
                s += __shfl_xor(s, 16); s += __shfl_xor(s, 32);
                if (fq == 0) tab[(ai * HALF + wr * 64 + m * 16 + fr) * 4 + wc] = s; }
        asm volatile("s_waitcnt lgkmcnt(0)" ::: "memory"); __builtin_amdgcn_s_barrier(); asm volatile("" ::: "memory");
#pragma unroll
        for (int ai = 0; ai < 2; ++ai)
#pragma unroll
            for (int m = 0; m < 4; ++m) { const int rl = ai * HALF + wr * 64 + m * 16 + fr; const f32x4 t = *(const PG8_LAS f32x4*)(tab + rl * 4); const float rs = 1.0f / sqrtf(((t[0] + t[1]) + (t[2] + t[3])) * (1.0f / 256.0f) + 1e-6f);
                bf16_t* rowp = O + (size_t)(row0 + ai * HALF + m * 16) * ldc + col0;
#pragma unroll
                for (int bj = 0; bj < 2; ++bj) { const f32x4 g0 = *(const f32x4*)(gain + col0 + bj * HALF), g1 = *(const f32x4*)(gain + col0 + bj * HALF + 4);
                    const f32x4 v0 = acc[ai][bj][m][0] * rs * g0, v1 = acc[ai][bj][m][1] * rs * g1;
                    u32x4 w; w.x = cvt_pk_bf16(v0[0], v0[1]); w.y = cvt_pk_bf16(v0[2], v0[3]); w.z = cvt_pk_bf16(v1[0], v1[1]); w.w = cvt_pk_bf16(v1[2], v1[3]);
                    *(u32x4*)(rowp + bj * HALF) = w; } }
    }
};
struct EpiScaleI8 {
    static constexpr bool PERM = true, AFTER_DRAIN = false;
    bf16_t* O; int ldc; const float* rsd; const float* wsc; PG8_LAS float* tab;
    __device__ __forceinline__ void pre(const Unit& u, int tid, int wid) const { const float* src = tid < 256 ? rsd + u.pm * BM + tid : wsc + u.pn * BM + (tid - 256);
        __builtin_amdgcn_global_load_lds((const unsigned*)src, (PG8_LAS unsigned*)(tab + u.par * 512 + wid * 64), 4, 0, 0); }
    __device__ __forceinline__ void operator()(const i32x4 (&acc)[2][2][4][2], const Unit& u, int wr, int wc, int fr, int fq) const {
        const int row0 = u.pm * BM + wr * 64 + fr, col0 = u.pn * BM + wc * 32 + 8 * fq;
        f32x4 sc[2][2];
#pragma unroll
        for (int bj = 0; bj < 2; ++bj) { sc[bj][0] = *(const PG8_LAS f32x4*)(tab + u.par * 512 + 256 + wc * 32 + 8 * fq + bj * HALF); sc[bj][1] = *(const PG8_LAS f32x4*)(tab + u.par * 512 + 256 + wc * 32 + 8 * fq + bj * HALF + 4); }
#pragma unroll
        for (int ai = 0; ai < 2; ++ai)
#pragma unroll
            for (int m = 0; m < 4; ++m) { const int r = row0 + ai * HALF + m * 16; const float rs = tab[u.par * 512 + wr * 64 + fr + ai * HALF + m * 16]; bf16_t* rowp = O + (size_t)r * ldc + col0;
#pragma unroll
                for (int bj = 0; bj < 2; ++bj) { f32x4 v0, v1;
#pragma unroll
                    for (int j = 0; j < 4; ++j) { v0[j] = (float)acc[ai][bj][m][0][j] * (rs * sc[bj][0][j]); v1[j] = (float)acc[ai][bj][m][1][j] * (rs * sc[bj][1][j]); }
                    u32x4 w; w.x = cvt_pk_bf16(v0[0], v0[1]); w.y = cvt_pk_bf16(v0[2], v0[3]); w.z = cvt_pk_bf16(v1[0], v1[1]); w.w = cvt_pk_bf16(v1[2], v1[3]);
                    *(u32x4*)(rowp + bj * HALF) = w; } }
    }
};
struct EpiSwigluI8 {
    static constexpr bool PERM = true, AFTER_DRAIN = false;
    bf16_t* O; int ldc; const float* rsd; const float* wsc; int wstride; PG8_LAS float* tab;
    __device__ __forceinline__ void pre(const Unit& u, int tid, int wid) const { const float* src = tid < 256 ? rsd + u.pm * BM + tid : wsc + (size_t)u.e * wstride + u.pn * BM + (tid - 256);
        __builtin_amdgcn_global_load_lds((const unsigned*)src, (PG8_LAS unsigned*)(tab + u.par * 512 + wid * 64), 4, 0, 0); }
    __device__ __forceinline__ void operator()(const i32x4 (&acc)[2][2][4][2], const Unit& u, int wr, int wc, int fr, int fq) const {
        const int row0 = u.pm * BM + wr * 64 + fr, col0 = u.pn * HALF + wc * 32 + 8 * fq;
        const PG8_LAS float* ws_ = tab + u.par * 512 + 256 + wc * 32 + 8 * fq;
        const f32x4 sg0 = *(const PG8_LAS f32x4*)ws_, sg1 = *(const PG8_LAS f32x4*)(ws_ + 4), su0 = *(const PG8_LAS f32x4*)(ws_ + HALF), su1 = *(const PG8_LAS f32x4*)(ws_ + HALF + 4);
#pragma unroll
        for (int ai = 0; ai < 2; ++ai)
#pragma unroll
            for (int m = 0; m < 4; ++m) { const int r = row0 + ai * HALF + m * 16; const float rs = tab[u.par * 512 + wr * 64 + fr + ai * HALF + m * 16];
                float o[8];
#pragma unroll
                for (int n = 0; n < 2; ++n)
#pragma unroll
                    for (int j = 0; j < 4; ++j) { const float g = (float)acc[ai][0][m][n][j] * (rs * (n ? sg1[j] : sg0[j])), up = (float)acc[ai][1][m][n][j] * (rs * (n ? su1[j] : su0[j])); o[4 * n + j] = g * up * __builtin_amdgcn_rcpf(1.0f + __expf(-g)); }
                u32x4 w; w.x = cvt_pk_bf16(o[0], o[1]); w.y = cvt_pk_bf16(o[2], o[3]); w.z = cvt_pk_bf16(o[4], o[5]); w.w = cvt_pk_bf16(o[6], o[7]);
                *(u32x4*)(O + (size_t)r * ldc + col0) = w; }
    }
};
template <> struct EpiPre<EpiScaleI8> { static constexpr bool v = true; };
template <> struct EpiPre<EpiSwigluI8> { static constexpr bool v = true; };
struct EpiSwiglu {
    static constexpr bool PERM = true, AFTER_DRAIN = false;
    bf16_t* O; int ldc; const float* ssq; const float* rsd;
    __device__ __forceinline__ void operator()(const f32x4 (&acc)[2][2][4][2], const Unit& u, int wr, int wc, int fr, int fq) const {
        const int row0 = u.pm * BM + wr * 64 + fr, col0 = u.pn * HALF + wc * 32 + 8 * fq;
#pragma unroll
        for (int ai = 0; ai < 2; ++ai)
#pragma unroll
            for (int m = 0; m < 4; ++m) { const int r = row0 + ai * HALF + m * 16; const float rs = rsd ? rsd[r] : rstd16(ssq, r);
                float o[8];
#pragma unroll
                for (int n = 0; n < 2; ++n)
#pragma unroll
                    for (int j = 0; j < 4; ++j) { const float g = acc[ai][0][m][n][j] * rs, up = acc[ai][1][m][n][j] * rs; o[4 * n + j] = g * up * __builtin_amdgcn_rcpf(1.0f + __expf(-g)); }
                u32x4 w; w.x = cvt_pk_bf16(o[0], o[1]); w.y = cvt_pk_bf16(o[2], o[3]); w.z = cvt_pk_bf16(o[4], o[5]); w.w = cvt_pk_bf16(o[6], o[7]);
                *(u32x4*)(O + (size_t)r * ldc + col0) = w; }
    }
};
template <class Epi, class Sched, bool ALIGN_EPI = false, bool SP2 = false, bool I8 = false>
__device__ __forceinline__ void gemm_phase(PG8_LAS unsigned char* lds, const Gemm g, const Sched& S, const Epi& E, int wave_in) {
    int wid_ = wave_in; unsigned ones_ = ~0u; asm volatile("" : "+s"(wid_), "+s"(ones_));
    const int wid = wid_, lane = (int)__builtin_amdgcn_mbcnt_hi(ones_, __builtin_amdgcn_mbcnt_lo(ones_, 0u)), tid = wid * 64 + lane, wr = wid >> 2, wc = wid & 3, fr = lane & 15, fq = lane >> 4;
    int K_ = g.K; asm volatile("" : "+s"(K_)); const int K = K_, nt = K / BK;
    unsigned voffA[2], voffB[2];
#pragma unroll
    for (int i = 0; i < 2; ++i) { int R, C; stage_rc(tid * 16 + i * 8192, R, C); const int Rb = Epi::PERM ? ((R & ~31) + perm32(R & 31)) : R;
        voffA[i] = (unsigned)(R * g.lda + C) * 2u; voffB[i] = (unsigned)(Rb * g.ldb + C) * 2u; }
    const size_t kstep = (size_t)(BK * 2);
    const size_t hstepA = (size_t)HALF * g.lda * 2, hstepB = (size_t)HALF * g.ldb * 2;
    const unsigned ldsw = (unsigned)wid * 1024u;
    const int aoff = lds_byte(wr * 64 + fr, fq * 8), boff = lds_byte(wc * 32 + fr, fq * 8);
#define PG8_SA(b, h) (((b) * 2 + (h)) * HTB)
#define PG8_SB(b, h) ((4 + (b) * 2 + (h)) * HTB)
#define PG8_STAGE(bufoff, gbase, voff) do { _Pragma("unroll") for (int _i = 0; _i < 2; ++_i) \
        __builtin_amdgcn_global_load_lds((const unsigned*)((const char*)(gbase) + (voff)[_i]), (PG8_LAS unsigned*)(lds + (bufoff) + ldsw + _i * 8192), 16, 0, 0); } while (0)
#define PG8_LDA(dst, b, h) do { _Pragma("unroll") for (int m = 0; m < 4; ++m) _Pragma("unroll") for (int k = 0; k < 2; ++k) dst[m][k] = *(const PG8_LAS bf16x8*)(lds + PG8_SA(b, h) + aoff + m * 2048 + k * 1024); } while (0)
#define PG8_LDA_H(dst, b, h, m0) do { _Pragma("unroll") for (int m = (m0); m < (m0) + 2; ++m) _Pragma("unroll") for (int k = 0; k < 2; ++k) dst[m][k] = *(const PG8_LAS bf16x8*)(lds + PG8_SA(b, h) + aoff + m * 2048 + k * 1024); } while (0)
#define PG8_LDB(dst, b, h) do { _Pragma("unroll") for (int n = 0; n < 2; ++n) _Pragma("unroll") for (int k = 0; k < 2; ++k) dst[n][k] = *(const PG8_LAS bf16x8*)(lds + PG8_SB(b, h) + boff + n * 2048 + k * 1024); } while (0)
#define PG8_MMA(ai, bj, At, Bt) do { __builtin_amdgcn_s_setprio(1); _Pragma("unroll") for (int m = 0; m < 4; ++m) _Pragma("unroll") for (int n = 0; n < 2; ++n) _Pragma("unroll") for (int k = 0; k < 2; ++k) \
        acc[ai][bj][m][n] = mma1<I8>(Bt[n][k], At[m][k], acc[ai][bj][m][n]); __builtin_amdgcn_s_setprio(0); } while (0)
#define PG8_WAIT_V(n) asm volatile("s_waitcnt vmcnt(" #n ")" ::: "memory")
#define PG8_WAIT_L(n) asm volatile("s_waitcnt lgkmcnt(" #n ")" ::: "memory")
#define PG8_BAR __builtin_amdgcn_s_barrier()
#define PG8_SCHED __builtin_amdgcn_sched_barrier(0)
    Unit cur, nxt; int ui = 0;
    if (!S.next(0, cur)) return;
    typedef typename AccSel<I8>::T AccV; AccV acc[2][2][4][2];
#pragma unroll
    for (int a = 0; a < 2; ++a)
#pragma unroll
        for (int b = 0; b < 2; ++b)
#pragma unroll
            for (int m = 0; m < 4; ++m)
#pragma unroll
                for (int n = 0; n < 2; ++n) { AccV z_{}; acc[a][b][m][n] = z_; }
    bf16x8 At[4][2], B0[2][2], B1[2][2];
    const char* cA = (const char*)g.A + cur.aoff; const char* cB = (const char*)g.Bt + cur.boff;
    S.a_ready(cur);
    if constexpr (SP2) {
        PG8_STAGE(PG8_SB(0, 0), cB, voffB); PG8_STAGE(PG8_SB(0, 1), cB + hstepB, voffB); PG8_STAGE(PG8_SA(0, 0), cA, voffA); PG8_STAGE(PG8_SA(0, 1), cA + hstepA, voffA);
        if (wr == 1) PG8_BAR;
        PG8_WAIT_V(2); PG8_BAR;
        PG8_STAGE(PG8_SB(1, 0), cB + kstep, voffB); PG8_STAGE(PG8_SA(1, 0), cA + kstep, voffA); PG8_STAGE(PG8_SB(1, 1), cB + hstepB + kstep, voffB);
        PG8_WAIT_V(6); PG8_BAR;
    } else {
        PG8_STAGE(PG8_SB(0, 0), cB, voffB); PG8_STAGE(PG8_SA(0, 0), cA, voffA); PG8_STAGE(PG8_SB(0, 1), cB + hstepB, voffB); PG8_STAGE(PG8_SA(0, 1), cA + hstepA, voffA);
        if (wr == 1) PG8_BAR;
        PG8_WAIT_V(4); PG8_BAR;
        PG8_STAGE(PG8_SB(1, 0), cB + kstep, voffB); PG8_STAGE(PG8_SA(1, 0), cA + kstep, voffA); PG8_STAGE(PG8_SB(1, 1), cB + hstepB + kstep, voffB);
        PG8_WAIT_V(6); PG8_BAR;
    }
    for (;;) {
        const bool has_next = S.next(ui + 1, nxt);
        const char* nA = has_next ? (const char*)g.A + nxt.aoff : cA; const char* nB = has_next ? (const char*)g.Bt + nxt.boff : cB;
        cur.par = ui & 1; if constexpr (EpiPre<Epi>::v) E.pre(cur, tid, wid);
        for (int t = 0; t < nt; t += 2) {
            const bool last = (t == nt - 2);
            const char* a1 = cA + (size_t)(t + 1) * kstep;
            const char* a2 = last ? nA : cA + (size_t)(t + 2) * kstep; const char* b2 = last ? nB : cB + (size_t)(t + 2) * kstep;
            const char* a3 = a2 + kstep; const char* b3 = b2 + kstep;
            if (last && has_next) S.a_ready(nxt);
            if constexpr (SP2) {
            PG8_LDB(B0, 0, 0); PG8_LDB(B1, 0, 1); PG8_SCHED; PG8_LDA_H(At, 0, 0, 0); PG8_WAIT_L(8); PG8_LDA_H(At, 0, 0, 2); PG8_STAGE(PG8_SA(1, 1), a1 + hstepA, voffA);
            PG8_WAIT_V(8); PG8_WAIT_L(0); PG8_BAR; PG8_MMA(0, 0, At, B0); PG8_MMA(0, 1, At, B1); PG8_BAR; PG8_SCHED;
            PG8_LDA(At, 0, 1); PG8_STAGE(PG8_SB(0, 0), b2, voffB); PG8_STAGE(PG8_SB(0, 1), b2 + hstepB, voffB); PG8_STAGE(PG8_SA(0, 0), a2, voffA);
            PG8_WAIT_V(8); PG8_WAIT_L(0); PG8_BAR; PG8_MMA(1, 0, At, B0); PG8_MMA(1, 1, At, B1); PG8_BAR; PG8_SCHED;
            PG8_LDB(B0, 1, 0); PG8_LDB(B1, 1, 1); PG8_SCHED; PG8_LDA_H(At, 1, 0, 0); PG8_WAIT_L(8); PG8_LDA_H(At, 1, 0, 2); PG8_STAGE(PG8_SA(0, 1), a2 + hstepA, voffA);
            PG8_WAIT_V(8); PG8_WAIT_L(0); PG8_BAR; PG8_MMA(0, 0, At, B0); PG8_MMA(0, 1, At, B1); PG8_BAR; PG8_SCHED;
            PG8_LDA(At, 1, 1); PG8_STAGE(PG8_SB(1, 0), b3, voffB); PG8_STAGE(PG8_SB(1, 1), b3 + hstepB, voffB); PG8_STAGE(PG8_SA(1, 0), a3, voffA);
            PG8_WAIT_V(8); PG8_WAIT_L(0); PG8_BAR; PG8_MMA(1, 0, At, B0); PG8_MMA(1, 1, At, B1); PG8_BAR; PG8_SCHED;
            } else {
            PG8_LDB(B0, 0, 0); PG8_SCHED; PG8_LDA(At, 0, 0); PG8_STAGE(PG8_SA(1, 1), a1 + hstepA, voffA);
            PG8_WAIT_L(8); PG8_BAR; PG8_WAIT_L(0); PG8_MMA(0, 0, At, B0); PG8_BAR; PG8_SCHED;
            PG8_LDB(B1, 0, 1); PG8_STAGE(PG8_SB(0, 0), b2, voffB);
            PG8_BAR; PG8_WAIT_L(0); PG8_MMA(0, 1, At, B1); PG8_BAR;
            PG8_LDA(At, 0, 1); PG8_STAGE(PG8_SA(0, 0), a2, voffA);
            PG8_BAR; PG8_WAIT_L(0); PG8_MMA(1, 0, At, B0); PG8_BAR; PG8_SCHED;
            PG8_STAGE(PG8_SB(0, 1), b2 + hstepB, voffB);
            PG8_WAIT_V(6); PG8_BAR; PG8_MMA(1, 1, At, B1); PG8_BAR;
            PG8_LDB(B0, 1, 0); PG8_SCHED; PG8_LDA(At, 1, 0); PG8_STAGE(PG8_SA(0, 1), a2 + hstepA, voffA);
            PG8_WAIT_L(8); PG8_BAR; PG8_WAIT_L(0); PG8_MMA(0, 0, At, B0); PG8_BAR; PG8_SCHED;
            PG8_LDB(B1, 1, 1); PG8_STAGE(PG8_SB(1, 0), b3, voffB);
            PG8_BAR; PG8_WAIT_L(0); PG8_MMA(0, 1, At, B1); PG8_BAR;
            PG8_LDA(At, 1, 1); PG8_STAGE(PG8_SA(1, 0), a3, voffA);
            PG8_BAR; PG8_WAIT_L(0); PG8_MMA(1, 0, At, B0); PG8_BAR; PG8_SCHED;
            PG8_STAGE(PG8_SB(1, 1), b3 + hstepB, voffB);
            PG8_WAIT_V(6); PG8_BAR; PG8_MMA(1, 1, At, B1); PG8_BAR;
            }
        }
        if constexpr (ALIGN_EPI) { if (wr == 0) PG8_BAR; }
        if constexpr (!Epi::AFTER_DRAIN) { E(acc, cur, wr, wc, fr, fq); S.done(cur); }
        if (!has_next) break;
#pragma unroll
        for (int a = 0; a < 2; ++a)
#pragma unroll
            for (int b = 0; b < 2; ++b)
#pragma unroll
                for (int m = 0; m < 4; ++m)
#pragma unroll
                    for (int n = 0; n < 2; ++n) { AccV z_{}; acc[a][b][m][n] = z_; }
        cur = nxt; cA = nA; cB = nB; ++ui;
        if constexpr (ALIGN_EPI) { if (wr == 1) PG8_BAR; }
    }
    PG8_WAIT_V(0);
    if constexpr (!ALIGN_EPI) { if (wr == 0) PG8_BAR; }
    PG8_BAR;
    if constexpr (Epi::AFTER_DRAIN) { E.fused(acc, cur, wr, wc, fr, fq, lds, wid, lane); S.done(cur); }
#undef PG8_SA
#undef PG8_SB
#undef PG8_STAGE
#undef PG8_LDA
#undef PG8_LDB
#undef PG8_MMA
#undef PG8_WAIT_V
#undef PG8_WAIT_L
#undef PG8_BAR
#undef PG8_SCHED
}
}

#define XB_TMO      128
#define XB_XCNT(j)  (256  + 64 * (j))
#define XB_XSUB(j)  (1280 + 64 * (j))
#define XB_XGEN(j)  (2304 + 64 * (j))
#define XB_TOP      3328
#define XB_TOPGEN   3392
#define XCD_BAR_WORDS 3456
#define XB_SPIN_CAP (1u << 22)
#define LAS __attribute__((address_space(3)))

__device__ __forceinline__ unsigned xb_ld(unsigned* p)              { return __hip_atomic_load(p, __ATOMIC_RELAXED, __HIP_MEMORY_SCOPE_AGENT); }
__device__ __forceinline__ unsigned xb_add(unsigned* p, unsigned v) { return __hip_atomic_fetch_add(p, v, __ATOMIC_RELAXED, __HIP_MEMORY_SCOPE_AGENT); }
__device__ __forceinline__ unsigned xb_xcc_id() { return (unsigned)__builtin_amdgcn_s_getreg((3 << 11) | 20) & 0xFu; }
#define XB_SPIN(cond, bar) do { unsigned _sp = 0; while (cond) { __builtin_amdgcn_s_sleep(1); \
    if ((++_sp & 255u) == 0u) { if (xb_ld(&(bar)[XB_TMO])) break; if (_sp > XB_SPIN_CAP) { atomicAdd(&(bar)[XB_TMO], 1u); break; } } } } while (0)

struct XcdBarrier {
    unsigned* bar; unsigned x;
    volatile LAS unsigned* st;
};

__device__ __forceinline__ XcdBarrier xcd_barrier_post(unsigned* bar, volatile LAS unsigned* st) {
    XcdBarrier b; b.bar = bar; b.x = xb_xcc_id(); b.st = st;
    if (threadIdx.x == 0) (void)xb_add(&bar[XB_XCNT(b.x)], 1u);
    return b;
}
__device__ __forceinline__ void xcd_barrier_complete(unsigned* bar, unsigned x, unsigned& nloc, unsigned& nx) {
    const unsigned G = gridDim.x * gridDim.y * gridDim.z;
    unsigned sum, cnt, mine, sp = 0u;
    for (;;) {
        sum = 0u; cnt = 0u; mine = 0u;
#pragma unroll
        for (unsigned j = 0; j < 16; ++j) { const unsigned c = xb_ld(&bar[XB_XCNT(j)]); sum += c; cnt += (c > 0u) ? 1u : 0u; mine = (j == x) ? c : mine; }
        if (sum == G) break;
        __builtin_amdgcn_s_sleep(1);
        if ((++sp & 255u) == 0u) { if (xb_ld(&bar[XB_TMO])) break; if (sp > XB_SPIN_CAP) { atomicAdd(&bar[XB_TMO], 1u); break; } }
    }
    nloc = mine > 0u ? mine : 1u; nx = cnt > 0u ? cnt : 1u;
}

__device__ __forceinline__ void xcd_barrier(const XcdBarrier& b) {
    asm volatile("s_waitcnt vmcnt(0)" ::: "memory");
    __syncthreads();
    if (threadIdx.x == 0) {
        unsigned* bar = b.bar;
        __builtin_amdgcn_s_waitcnt(0);
        unsigned nloc = b.st[0], nx = b.st[1];
        if (nloc == 0u) { xcd_barrier_complete(bar, b.x, nloc, nx); b.st[0] = nloc; b.st[1] = nx; }
        const unsigned old = xb_add(&bar[XB_XSUB(b.x)], 1u);
        const unsigned gen = old / nloc;
        if (old + 1u == (gen + 1u) * nloc) {
            __builtin_amdgcn_fence(__ATOMIC_RELEASE, "agent");
            asm volatile("s_waitcnt vmcnt(0)" ::: "memory");
            const unsigned og = xb_add(&bar[XB_TOP], 1u);
            const unsigned tg = og / nx;
            if (og + 1u == (tg + 1u) * nx) xb_add(&bar[XB_TOPGEN], 1u);
            else XB_SPIN(xb_ld(&bar[XB_TOPGEN]) == tg, bar);
            __builtin_amdgcn_fence(__ATOMIC_ACQUIRE, "agent");
            xb_add(&bar[XB_XGEN(b.x)], 1u);
            asm volatile("s_waitcnt vmcnt(0)" ::: "memory");
        } else {
            XB_SPIN(xb_ld(&bar[XB_XGEN(b.x)]) == gen, bar);
            __builtin_amdgcn_fence(__ATOMIC_ACQUIRE, "agent");
            asm volatile("s_waitcnt vmcnt(0)" ::: "memory");
        }
    }
    __syncthreads();
}

constexpr int NB = 16, SEQ = 2048, DM = 1024, NL = 4, MEMLEN = 256, INC = 2816, FF = 2816, NEXP = 8;
constexpr int T = NB * SEQ;
constexpr int MROWS = NB * MEMLEN;
constexpr int MOE_ROWS = 2 * T + NEXP * 256;
constexpr int O_RET = 256, O_SB = 1280;
constexpr float NORM_EPS = 1e-6f;

constexpr size_t MiB = 1u << 20;
constexpr size_t WS_CTL = 0;
constexpr size_t WS_SSQ = 1 * MiB;
constexpr size_t WS_ROPE = 3 * MiB;
constexpr size_t WS_WR = 3 * MiB + 512 * 1024;
constexpr size_t WS_MOEI = 4 * MiB;
constexpr size_t WS_MEMN = 8 * MiB;
constexpr size_t WS_KC = 16 * MiB;
constexpr size_t WS_VT = 48 * MiB;
constexpr size_t WS_H = 80 * MiB;
constexpr size_t WS_WIN = 144 * MiB, WS_WGLU = 166 * MiB, WS_WOUT = 167 * MiB, WS_WCQ = 175 * MiB, WS_WCK = 183 * MiB, WS_WCV = 191 * MiB, WS_WCO = 199 * MiB;
constexpr size_t WS_WDGU = 207 * MiB, WS_WDDN = 229 * MiB, WS_WEGU = 240 * MiB, WS_WEDN = 416 * MiB;
constexpr size_t WS_AR = 504 * MiB;
constexpr size_t AR_PROJ = WS_AR, AR_Y = WS_AR + 176 * MiB, AR_G = WS_AR + 240 * MiB, AR_Z = WS_AR + 256 * MiB, AR_XS = WS_AR + 272 * MiB;
constexpr size_t AR_QC = WS_AR, AR_SC = WS_AR + 64 * MiB, AR_PB = WS_AR + 192 * MiB, AR_OC = WS_AR + 256 * MiB;
constexpr size_t AR_ACT = WS_AR;
constexpr size_t AR_XG = WS_AR, AR_ACTG = WS_AR + 132 * MiB, AR_DG = WS_AR + 495 * MiB;
constexpr size_t WS_WK = WS_AR + 627 * MiB;
constexpr size_t WS_VO = WS_WK + 32 * MiB;
constexpr size_t WS_Q8W = WS_VO + 32 * MiB;
constexpr size_t WS_Q8S = WS_Q8W + 100 * MiB;
constexpr size_t WS_Q8IN = WS_Q8S + 1 * MiB;
constexpr size_t WS_Q8INS = WS_Q8IN + 11 * MiB;
constexpr size_t WS_END = WS_Q8INS + 1 * MiB;
static_assert((size_t)18 * 2 * FF * DM <= 100 * MiB, "int8 weight region");
static_assert((size_t)T * INC * 2 <= 176 * MiB && (size_t)T * 16 * 128 * 4 <= 256 * MiB && (size_t)MOE_ROWS * 1024 * 2 <= 132 * MiB && (size_t)MOE_ROWS * FF * 2 <= 363 * MiB, "arena map");
constexpr size_t MI_CNT = 0, MI_EST = 16384, MI_TOPI = 32768, MI_TOPG = MI_TOPI + (size_t)T * 8, MI_RSTD = MI_TOPG + (size_t)T * 8, MI_POS = MI_RSTD + (size_t)T * 4, MI_RSTDG = MI_POS + (size_t)T * 8, MI_RSC0 = 2 * MiB;
static_assert(MI_RSTDG + (size_t)MOE_ROWS * 4 <= 2 * MiB && MI_RSC0 + (size_t)T * 4 <= 4 * MiB, "moe tables");

constexpr int RING_BYTES = 131072;
constexpr int MISC_OFF = RING_BYTES + 320;
constexpr int TAB_OFF = MISC_OFF + 128;
constexpr int LDS_BYTES = 147456;

#define GAS __attribute__((address_space(1)))
typedef unsigned short bf16;
typedef unsigned v4u __attribute__((ext_vector_type(4)));
typedef unsigned v2u __attribute__((ext_vector_type(2)));
typedef float f32x4 __attribute__((ext_vector_type(4)));
__device__ __forceinline__ float bf2f(unsigned v) { return __uint_as_float(v << 16); }
__device__ __forceinline__ float bflo(unsigned w) { return __uint_as_float(w << 16); }
__device__ __forceinline__ float bfhi(unsigned w) { return __uint_as_float(w & 0xffff0000u); }
__device__ __forceinline__ unsigned f2bf(float f) { unsigned u = __float_as_uint(f); return (u + 0x7fffu + ((u >> 16) & 1u)) >> 16; }
__device__ __forceinline__ unsigned pk2(float lo, float hi) { return f2bf(lo) | (f2bf(hi) << 16); }
__device__ __forceinline__ float wave_sum(float v) {
#pragma unroll
    for (int o = 1; o < 64; o <<= 1) v += __shfl_xor(v, o);
    return v;
}
__device__ __forceinline__ float wave_max(float v) {
#pragma unroll
    for (int o = 1; o < 64; o <<= 1) v = fmaxf(v, __shfl_xor(v, o));
    return v;
}
__device__ __forceinline__ void unpack8(const v4u w, float* f) { f[0] = bflo(w.x); f[1] = bfhi(w.x); f[2] = bflo(w.y); f[3] = bfhi(w.y); f[4] = bflo(w.z); f[5] = bfhi(w.z); f[6] = bflo(w.w); f[7] = bfhi(w.w); }
__device__ __forceinline__ void load64(const bf16* p, float* f) {
#pragma unroll
    for (int i = 0; i < 8; ++i) unpack8(((const v4u*)p)[i], f + 8 * i);
}
__device__ __forceinline__ float rstd16(const float* ssq, int r) { return pg8::rstd16(ssq, r); }

struct P { const float* in[27]; float* out; unsigned char* ws; int ph_lo, ph_hi; };
typedef const __attribute__((address_space(4))) P* KP;

__device__ __forceinline__ v2u q8_pack8(const float* v, float inv) { unsigned b[8];
#pragma unroll
    for (int j = 0; j < 8; ++j) b[j] = (unsigned)(int)__builtin_rintf(v[j] * inv) & 0xffu;
    v2u o; o.x = b[0] | (b[1] << 8) | (b[2] << 16) | (b[3] << 24); o.y = b[4] | (b[5] << 8) | (b[6] << 16) | (b[7] << 24); return o; }
__device__ __forceinline__ float absmax16(const float* a, const float* b) { float m = 0.f;
#pragma unroll
    for (int j = 0; j < 8; ++j) m = fmaxf(m, fmaxf(fabsf(a[j]), fabsf(b[j])));
    return wave_max(m); }

struct TrD { const float* W; bf16* WT; const float* wn; float sc; int ldw, K, mode, k0, n0; };
__device__ __forceinline__ TrD tr_desc(KP p, GAS unsigned char* ws, int it) {
    constexpr int I_GLU = 4 * 1, I_SQ = 16 * 4, I_DN = 44 * 4;
    constexpr int E0 = 0, E1 = E0 + 4 * I_GLU, E2 = E1 + 4 * I_SQ, E3 = E2, E4 = E3 + 4 * I_SQ, E5 = E4 + 4 * I_SQ, E6 = E5 + 4 * I_SQ, E8 = E6 + 2 * I_DN;
    TrD d; d.wn = nullptr; d.sc = 1.f; d.mode = 0; int item, N;
    if (it < E1) { const int r = it - E0, l = r / I_GLU; item = r % I_GLU; d.W = ((const float*)(GAS const float*)p->in[12]) + (size_t)l * 256 * 256; d.ldw = 256; d.K = 256; N = 256; d.WT = (bf16*)(ws + WS_WGLU) + (size_t)l * 256 * 256; }
    else if (it < E2) { const int r = it - E1, l = r / I_SQ; item = r % I_SQ; d.W = ((const float*)(GAS const float*)p->in[14]) + (size_t)l * DM * DM; d.ldw = DM; d.K = DM; N = DM; d.WT = (bf16*)(ws + WS_WOUT) + (size_t)l * DM * DM; }
    else if (it < E4) { const int r = it - E3, l = r / I_SQ; item = r % I_SQ; d.W = ((const float*)(GAS const float*)p->in[18]) + (size_t)l * DM * 2 * DM; d.ldw = 2 * DM; d.K = DM; N = DM; d.WT = (bf16*)(ws + WS_WCK) + (size_t)l * DM * DM; }
    else if (it < E5) { const int r = it - E4, l = r / I_SQ; item = r % I_SQ; d.W = ((const float*)(GAS const float*)p->in[18]) + (size_t)l * DM * 2 * DM + DM; d.ldw = 2 * DM; d.K = DM; N = DM; d.WT = (bf16*)(ws + WS_WCV) + (size_t)l * DM * DM; }
    else if (it < E6) { const int r = it - E5, l = r / I_SQ; item = r % I_SQ; d.W = ((const float*)(GAS const float*)p->in[19]) + (size_t)l * DM * DM; d.ldw = DM; d.K = DM; N = DM; d.WT = (bf16*)(ws + WS_WCO) + (size_t)l * DM * DM; }
    else if (it < E8) { const int r = it - E6, i = r / I_DN; item = r % I_DN; d.W = ((const float*)(GAS const float*)p->in[22]) + (size_t)i * FF * DM; d.ldw = DM; d.K = FF; N = DM; d.WT = (bf16*)(ws + WS_WDDN) + (size_t)i * DM * FF; }
    else              { const int r = it - E8, ie = r / I_DN; item = r % I_DN; d.W = ((const float*)(GAS const float*)p->in[25]) + (size_t)ie * FF * DM; d.ldw = DM; d.K = FF; N = DM; d.WT = (bf16*)(ws + WS_WEDN) + (size_t)ie * DM * FF; }
    const int nblk = N / 256; d.k0 = 64 * (item / nblk); d.n0 = 256 * (item % nblk);
    return d;
}
constexpr int TR_TOTAL = 4 * 4 + 4 * 4 * 64 + 2 * 176 + 16 * 176;
__device__ __forceinline__ void tr_load(const TrD& d, f32x4 (&v)[8], int tid) {
    const float* src = d.W + (size_t)(d.k0 + (tid >> 6)) * d.ldw + d.n0 + 4 * (tid & 63);
#pragma unroll
    for (int i = 0; i < 8; ++i) v[i] = *(const f32x4*)(src + (size_t)(8 * i) * d.ldw);
}
struct SqD { const float* W; const float* wn; unsigned char* Q; float* QS; int ldw, n0, dr0; };
constexpr int SQ_GU = 18 * 176, SQ_TOTAL = SQ_GU + 4 * 88;
__device__ __forceinline__ SqD sq_desc(KP p, GAS unsigned char* ws, int s) {
    SqD d;
    if (s < SQ_GU) { const int m = s / 176, j = s % 176; const int n = 32 * j, jj = n >= FF ? n - FF : n; d.n0 = n; d.ldw = 2 * FF; d.dr0 = (jj / 128) * 256 + (jj % 128) + (n >= FF ? 128 : 0);
        if (m < 2) { d.W = ((const float*)(GAS const float*)p->in[21]) + (size_t)m * DM * 2 * FF; d.wn = ((const float*)(GAS const float*)p->in[20]) + (2 * m) * DM; }
        else { const int ie = m - 2; d.W = ((const float*)(GAS const float*)p->in[24]) + (size_t)ie * DM * 2 * FF; d.wn = ((const float*)(GAS const float*)p->in[20]) + (2 * (ie / NEXP) + 1) * DM; }
        d.Q = (unsigned char*)(ws + WS_Q8W) + (size_t)m * 2 * FF * DM; d.QS = (float*)(ws + WS_Q8S) + (size_t)m * 2 * FF; }
    else { const int r = s - SQ_GU, l = r / 88, j = r % 88; d.n0 = 32 * j; d.dr0 = 32 * j; d.ldw = INC; d.W = ((const float*)(GAS const float*)p->in[3]) + (size_t)l * DM * INC; d.wn = ((const float*)(GAS const float*)p->in[2]) + l * DM;
        d.Q = (unsigned char*)(ws + WS_Q8IN) + (size_t)l * INC * DM; d.QS = (float*)(ws + WS_Q8INS) + (size_t)l * INC; }
    return d;
}
__device__ __forceinline__ void sq_load(const SqD& d, f32x4 (&v)[16], int tid) {
    const float* src = d.W + (size_t)(tid >> 3) * d.ldw + d.n0 + 4 * (tid & 7);
#pragma unroll
    for (int i = 0; i < 16; ++i) v[i] = *(const f32x4*)(src + (size_t)(64 * i) * d.ldw);
}
__device__ __forceinline__ void phase_prologue(KP p, GAS unsigned char* ws, LAS unsigned char* lds, int bid, int G, int gw, int NGW, int wave, int lane, int tid) {
    {   int it = bid; SqD cur, nxt; f32x4 v[16];
        if (it < SQ_TOTAL) { cur = sq_desc(p, ws, it); sq_load(cur, v, tid); }
        while (it < SQ_TOTAL) {
            { const int kr = tid >> 3, ch = tid & 7;
#pragma unroll
              for (int i = 0; i < 16; ++i) { const int k = 64 * i + kr; const float s = cur.wn[k]; LAS unsigned short* d = (LAS unsigned short*)(lds + (4 * ch) * 2048 + (((k >> 3) ^ ch) << 4) + 2 * (k & 7));
#pragma unroll
                  for (int e = 0; e < 4; ++e) d[e * 1024] = (unsigned short)f2bf(v[i][e] * s);
                  if ((i & 1) == 1) asm volatile("s_waitcnt lgkmcnt(0)" ::: "memory"); } }
            __syncthreads();
            const int itn = it + G;
            if (itn < SQ_TOTAL) { nxt = sq_desc(p, ws, itn); sq_load(nxt, v, tid); }
#pragma unroll
            for (int j = 0; j < 4; ++j) { const int row = 4 * wave + j; const LAS unsigned char* src = lds + row * 2048; float a[8], b2[8];
                unpack8(*(const LAS v4u*)(src + ((lane ^ wave) << 4)), a); unpack8(*(const LAS v4u*)(src + (((64 + lane) ^ wave) << 4)), b2);
                const float mx = absmax16(a, b2), step = mx > 0.f ? mx * (1.0f / 127.0f) : 1.0f, inv = 1.0f / step;
                unsigned char* qd = cur.Q + (size_t)(cur.dr0 + row) * DM;
                ((v2u*)qd)[lane] = q8_pack8(a, inv); ((v2u*)(qd + 512))[lane] = q8_pack8(b2, inv);
                if (lane == 0) cur.QS[cur.dr0 + row] = step; }
            __syncthreads();
            it = itn; cur = nxt;
        }
    }
    {   LAS float* T0 = (LAS float*)lds;
        int it = bid; TrD cur, nxt; f32x4 v[8];
        if (it < TR_TOTAL) { cur = tr_desc(p, ws, it); tr_load(cur, v, tid); }
        while (it < TR_TOTAL) {
            { const int r = tid >> 6, ch = tid & 63;
#pragma unroll
              for (int i = 0; i < 8; ++i) { const int k = 8 * i + r; const float s = cur.wn ? cur.wn[cur.k0 + k] * cur.sc : cur.sc; *(LAS f32x4*)(T0 + k * 256 + ((ch ^ (i & 7)) << 2)) = v[i] * s; } }
            __syncthreads();
            const int itn = it + G;
            if (itn < TR_TOTAL) { nxt = tr_desc(p, ws, itn); tr_load(nxt, v, tid); }
            { const int c = tid & 7;
#pragma unroll
              for (int j = 0; j < 4; ++j) { const int nn = (tid >> 3) + 64 * j; const LAS float* s = T0 + (8 * c) * 256 + ((((nn >> 2) ^ c) << 2) | (nn & 3));
                  v4u o; o.x = pk2(s[0 * 256], s[1 * 256]); o.y = pk2(s[2 * 256], s[3 * 256]); o.z = pk2(s[4 * 256], s[5 * 256]); o.w = pk2(s[6 * 256], s[7 * 256]);
                  const int n = cur.n0 + nn; int dr = n; if (cur.mode == 1) { const int jj = n >= FF ? n - FF : n; dr = (jj / 128) * 256 + (jj % 128) + (n >= FF ? 128 : 0); }
                  *(v4u*)(cur.WT + (size_t)dr * cur.K + cur.k0 + 8 * c) = o; } }
            __syncthreads();
            it = itn; cur = nxt;
        }
    }
    { const float* x = ((const float*)(GAS const float*)p->in[0]); bf16* H = (bf16*)(ws + WS_H); float* SSQ = (float*)(ws + WS_SSQ); unsigned char* HQ = (unsigned char*)(ws + AR_Y); float* RSC0 = (float*)(ws + WS_MOEI + MI_RSC0);
      for (int m = gw; m < T; m += NGW) { const f32x4* xr = (const f32x4*)(x + (size_t)m * DM) + lane; float s = 0.f, mx = 0.f; float hv[4][4];
#pragma unroll
          for (int j = 0; j < 4; ++j) { const f32x4 v = xr[64 * j]; const unsigned w0 = pk2(v[0], v[1]), w1 = pk2(v[2], v[3]);
              hv[j][0] = bflo(w0); hv[j][1] = bfhi(w0); hv[j][2] = bflo(w1); hv[j][3] = bfhi(w1);
#pragma unroll
              for (int e = 0; e < 4; ++e) { s += hv[j][e] * hv[j][e]; mx = fmaxf(mx, fabsf(hv[j][e])); }
              ((unsigned long long*)(H + (size_t)m * DM))[lane + 64 * j] = (unsigned long long)w0 | ((unsigned long long)w1 << 32); }
          s = wave_sum(s); mx = wave_max(mx); if (lane < 16) SSQ[(size_t)m * 16 + lane] = lane == 0 ? s : 0.f;
          const float step = mx > 0.f ? mx * (1.0f / 127.0f) : 1.0f, inv = 1.0f / step;
#pragma unroll
          for (int j = 0; j < 4; ++j) { unsigned q = 0u;
#pragma unroll
              for (int e = 0; e < 4; ++e) q |= ((unsigned)(int)__builtin_rintf(hv[j][e] * inv) & 0xffu) << (8 * e);
              ((unsigned*)(HQ + (size_t)m * DM))[lane + 64 * j] = q; }
          if (lane == 0) RSC0[m] = step / sqrtf(s * (1.0f / DM) + NORM_EPS); } }
    { const float* mem = ((const float*)(GAS const float*)p->in[1]); const float* w = ((const float*)(GAS const float*)p->in[16]); bf16* MN = (bf16*)(ws + WS_MEMN);
      for (int m = gw; m < MROWS; m += NGW) { const f32x4* xr = (const f32x4*)(mem + (size_t)m * DM) + lane; f32x4 v[4]; float s = 0.f;
#pragma unroll
          for (int j = 0; j < 4; ++j) { v[j] = xr[64 * j]; s += (v[j][0] * v[j][0] + v[j][1] * v[j][1]) + (v[j][2] * v[j][2] + v[j][3] * v[j][3]); }
          const float rs = 1.0f / sqrtf(wave_sum(s) * (1.0f / DM) + NORM_EPS);
#pragma unroll
          for (int j = 0; j < 4; ++j) { const f32x4 g = ((const f32x4*)w)[lane + 64 * j]; const unsigned w0 = pk2(v[j][0] * rs * g[0], v[j][1] * rs * g[1]), w1 = pk2(v[j][2] * rs * g[2], v[j][3] * rs * g[3]);
              ((unsigned long long*)(MN + (size_t)m * DM))[lane + 64 * j] = (unsigned long long)w0 | ((unsigned long long)w1 << 32); } } }
    { bf16* WQN = (bf16*)(ws + WS_WCQ); const float sc = 0.0625f * 1.4426950408889634f;
      for (size_t i8 = (size_t)gw * 64 + lane; i8 < (size_t)NL * DM * DM / 8; i8 += (size_t)NGW * 64) { const size_t e0 = i8 * 8; const int l = (int)(e0 / ((size_t)DM * DM)), k = (int)((e0 / DM) % DM);
          const f32x4 a = *(const f32x4*)(((const float*)(GAS const float*)p->in[17]) + e0), b2 = *(const f32x4*)(((const float*)(GAS const float*)p->in[17]) + e0 + 4); const float s = ((const float*)(GAS const float*)p->in[15])[l * DM + k] * sc;
          v4u o; o.x = pk2(a[0] * s, a[1] * s); o.y = pk2(a[2] * s, a[3] * s); o.z = pk2(b2[0] * s, b2[1] * s); o.w = pk2(b2[2] * s, b2[3] * s); *(v4u*)(WQN + e0) = o; } }
    { float* ROPE = (float*)(ws + WS_ROPE);
      for (int idx = gw * 64 + lane; idx < SEQ * 32; idx += NGW * 64) { const int pos = idx >> 5, i = idx & 31; const float invf = (float)pow(10000.0, -(double)i / 32.0); const float ang = (float)pos * invf;
          ROPE[2 * idx] = (float)cos((double)ang); ROPE[2 * idx + 1] = (float)sin((double)ang); }
      float* WR = (float*)(ws + WS_WR);
      for (int idx = gw * 64 + lane; idx < 2 * DM * NEXP; idx += NGW * 64) { const int i = idx / (DM * NEXP), k = (idx / NEXP) % DM; WR[idx] = ((const float*)(GAS const float*)p->in[23])[idx] * ((const float*)(GAS const float*)p->in[20])[(2 * i + 1) * DM + k]; } }
}


typedef short s16x8 __attribute__((ext_vector_type(8)));
typedef short s16x4 __attribute__((ext_vector_type(4)));
typedef _Float16 h16x8 __attribute__((ext_vector_type(8)));
typedef float f32x16 __attribute__((ext_vector_type(16)));
constexpr int AT_KSTR = 144, AT_VSTR = 136;
constexpr int AT_KS = 0, AT_VS = 2 * 64 * AT_KSTR, AT_FLAG = AT_VS + 2 * 64 * AT_VSTR, AT_SIN = AT_FLAG + 64, AT_UNIT = MISC_OFF + 64;
constexpr int RS_STR = 520, RS_KT = 0, RS_VT = 64 * RS_STR;
constexpr unsigned RS_UNITS = 64 * 7;
__device__ __forceinline__ int crow(int reg, int h) { return (reg & 3) + 8 * (reg >> 2) + 4 * h; }
__device__ __forceinline__ unsigned cvtpk_bf16(float lo, float hi) { unsigned r; asm volatile("v_cvt_pk_bf16_f32 %0, %1, %2" : "=v"(r) : "v"(lo), "v"(hi)); return r; }

template <int MODE>
__device__ __forceinline__ void attn_unit(const bf16* PROJ, bf16* Y, const float* ROPE, const float* gain, const float* SLOC, unsigned* ctrA, int bh, int qb, LAS unsigned char* lds, int wave, int lane, int tid) {
    constexpr int NH = MODE == 0 ? 8 : 4, QCOL = MODE == 0 ? O_SB : O_RET, KCOL = QCOL + (MODE == 0 ? 512 : 256), VCOL = KCOL + (MODE == 0 ? 512 : 256), YCOL = MODE == 0 ? 512 : 256;
    const int b = bh / NH, hd = bh % NH, r = lane & 31, h = lane >> 5;
    const int n0 = qb * 256 + wave * 32;
    const size_t rowb = (size_t)b * SEQ;
    s16x8 qf[4];
    { const bf16* qp = PROJ + (rowb + n0 + r) * INC + QCOL + hd * 64;
      float q[4][8];
#pragma unroll
      for (int s = 0; s < 4; ++s) unpack8(*(const v4u*)(qp + 16 * s + 8 * h), q[s]);
      if (MODE == 1) { const float* rp = ROPE + (size_t)(n0 + r) * 64;
#pragma unroll
          for (int s = 0; s < 2; ++s)
#pragma unroll
              for (int j = 0; j < 8; ++j) { const int i = 16 * s + 8 * h + j; const float cs = rp[2 * i], sn = rp[2 * i + 1]; const float x1 = q[s][j], x2 = q[s + 2][j]; q[s][j] = x1 * cs - x2 * sn; q[s + 2][j] = x1 * sn + x2 * cs; } }
      const float qs = MODE == 0 ? 0.125f * 1.4426950408889634f : 0.125f;
#pragma unroll
      for (int s = 0; s < 4; ++s) { v4u w; w.x = cvtpk_bf16(q[s][0] * qs, q[s][1] * qs); w.y = cvtpk_bf16(q[s][2] * qs, q[s][3] * qs); w.z = cvtpk_bf16(q[s][4] * qs, q[s][5] * qs); w.w = cvtpk_bf16(q[s][6] * qs, q[s][7] * qs); qf[s] = __builtin_bit_cast(s16x8, w); } }
    h16x8 uf[2];
    float dl[16]; float lg = 0.f;
    if (MODE == 0) {
#pragma unroll
        for (int s = 0; s < 2; ++s)
#pragma unroll
            for (int j = 0; j < 8; ++j) uf[s][j] = (16 * s + 8 * (j >> 2) + 4 * h + (j & 3)) >= r ? (_Float16)1.0f : (_Float16)0.0f;
    } else { lg = log2f(1.0f - exp2f(-5.0f - (float)hd));
#pragma unroll
        for (int i = 0; i < 16; ++i) dl[i] = exp2f(lg * (float)(r - crow(i, h))); }
    f32x16 o0, o1;
#pragma unroll
    for (int i = 0; i < 16; ++i) { o0[i] = 0.f; o1[i] = 0.f; }
    if (MODE == 1 && qb > 0) {
        if (tid == 0) { unsigned sp = 0; while (__hip_atomic_load(ctrA, __ATOMIC_RELAXED, __HIP_MEMORY_SCOPE_AGENT) < RS_UNITS) { __builtin_amdgcn_s_sleep(2); if (++sp > (1u << 22)) break; }
            __builtin_amdgcn_fence(__ATOMIC_ACQUIRE, "agent"); asm volatile("s_waitcnt vmcnt(0)" ::: "memory"); }
        __syncthreads();
        { float acc8[8];
#pragma unroll
          for (int j = 0; j < 8; ++j) acc8[j] = 0.f;
          const float g256 = exp2f(lg * 256.0f);
          for (int j = 0; j < qb; ++j) { const f32x4* sp4 = (const f32x4*)(SLOC + ((size_t)(bh * 7 + j) * 4096 + tid * 8)); const f32x4 s0 = sp4[0], s1 = sp4[1];
#pragma unroll
              for (int e = 0; e < 4; ++e) { acc8[e] = acc8[e] * g256 + s0[e]; acc8[4 + e] = acc8[4 + e] * g256 + s1[e]; } }
          v4u w; w.x = cvtpk_bf16(acc8[0], acc8[1]); w.y = cvtpk_bf16(acc8[2], acc8[3]); w.z = cvtpk_bf16(acc8[4], acc8[5]); w.w = cvtpk_bf16(acc8[6], acc8[7]);
          *(LAS v4u*)(lds + AT_SIN + (tid >> 3) * AT_KSTR + (tid & 7) * 16) = w; }
        __syncthreads();
        const LAS unsigned char* sb = lds + AT_SIN + r * AT_KSTR + 16 * h;
#pragma unroll
        for (int s = 0; s < 4; ++s) { const s16x8 a0 = *(const LAS s16x8*)(sb + 32 * s), a1 = *(const LAS s16x8*)(sb + 32 * AT_KSTR + 32 * s);
            o0 = __builtin_amdgcn_mfma_f32_32x32x16_bf16(a0, qf[s], o0, 0, 0, 0); o1 = __builtin_amdgcn_mfma_f32_32x32x16_bf16(a1, qf[s], o1, 0, 0, 0); }
        const float rsc = exp2f(lg * (float)(32 * wave + r + 1));
#pragma unroll
        for (int i = 0; i < 16; ++i) { o0[i] *= rsc; o1[i] *= rsc; }
    }
    float carry = 0.f; bool wdone = false;
    const int st_row = (tid & 255) >> 2, st_c = tid & 3; const bool st_k = tid < 256;
    const int kt_first = 4 * qb + 3, kt_lo = MODE == 1 ? 4 * qb : 0;
    struct SR { v4u g0, g1; f32x4 rp4[4]; };
    auto stage_load = [&](int kt, SR& R) { const bf16* src = PROJ + (rowb + 64 * kt + st_row) * INC + (st_k ? KCOL : VCOL) + hd * 64 + 8 * st_c; R.g0 = *(const v4u*)src; R.g1 = *(const v4u*)(src + 32);
        if (MODE == 1 && st_k) { const f32x4* rq = (const f32x4*)(ROPE + (size_t)(64 * kt + st_row) * 64 + 16 * st_c);
#pragma unroll
            for (int j = 0; j < 4; ++j) R.rp4[j] = rq[j]; } };
    auto stage_store = [&](int buf, SR& R) {
        v4u g0 = R.g0, g1 = R.g1;
        if (st_k) {
            if (MODE == 1) { float a[8], c2[8]; unpack8(g0, a); unpack8(g1, c2);
#pragma unroll
                for (int j = 0; j < 8; ++j) { const float cs = R.rp4[j >> 1][2 * (j & 1)], sn = R.rp4[j >> 1][2 * (j & 1) + 1]; const float x1 = a[j], x2 = c2[j]; a[j] = x1 * cs - x2 * sn; c2[j] = x1 * sn + x2 * cs; }
                g0.x = cvtpk_bf16(a[0], a[1]); g0.y = cvtpk_bf16(a[2], a[3]); g0.z = cvtpk_bf16(a[4], a[5]); g0.w = cvtpk_bf16(a[6], a[7]);
                g1.x = cvtpk_bf16(c2[0], c2[1]); g1.y = cvtpk_bf16(c2[2], c2[3]); g1.z = cvtpk_bf16(c2[4], c2[5]); g1.w = cvtpk_bf16(c2[6], c2[7]); }
            LAS unsigned char* d = lds + AT_KS + buf * 64 * AT_KSTR + st_row * AT_KSTR + 16 * st_c; *(LAS v4u*)d = g0; *(LAS v4u*)(d + 64) = g1;
        } else {
            LAS unsigned short* d = (LAS unsigned short*)(lds + AT_VS + buf * 64 * AT_VSTR + (8 * st_c) * AT_VSTR + 2 * st_row);
            const unsigned w0[4] = {g0.x, g0.y, g0.z, g0.w}, w1[4] = {g1.x, g1.y, g1.z, g1.w};
#pragma unroll
            for (int j = 0; j < 4; ++j) { d[(2 * j) * (AT_VSTR / 2)] = (unsigned short)(w0[j] & 0xffffu); d[(2 * j + 1) * (AT_VSTR / 2)] = (unsigned short)(w0[j] >> 16);
                d[(32 + 2 * j) * (AT_VSTR / 2)] = (unsigned short)(w1[j] & 0xffffu); d[(32 + 2 * j + 1) * (AT_VSTR / 2)] = (unsigned short)(w1[j] >> 16);
                if (j & 1) asm volatile("s_waitcnt lgkmcnt(0)" ::: "memory"); }
        } };
    LAS unsigned* flags = (LAS unsigned*)(lds + AT_FLAG);
    SR RA, RB;
    stage_load(kt_first, RA); stage_store(0, RA);
    stage_load(kt_first - 1, RA);
    __syncthreads();
    auto compute = [&](int kt, int buf) {
        if (!wdone) {
#pragma unroll
            for (int sub = 1; sub >= 0; --sub) {
                const int k0 = 64 * kt + 32 * sub;
                if (k0 <= n0) {
                    const bool diag = (k0 == n0);
                    const LAS unsigned char* kb = lds + AT_KS + buf * 64 * AT_KSTR + (32 * sub + r) * AT_KSTR + 16 * h;
                    f32x16 st;
#pragma unroll
                    for (int i = 0; i < 16; ++i) st[i] = 0.f;
#pragma unroll
                    for (int s = 0; s < 4; ++s) { const s16x8 kf = *(const LAS s16x8*)(kb + 32 * s); st = __builtin_amdgcn_mfma_f32_32x32x16_bf16(kf, qf[s], st, 0, 0, 0); }
                    float w[16];
                    if (MODE == 0) {
                        float sp[16];
#pragma unroll
                        for (int i = 0; i < 16; ++i) { const float z = st[i]; const float t = __builtin_amdgcn_exp2f(-fabsf(z)); sp[i] = __builtin_fmaf(0.5f, z, __builtin_fmaf(0.5f, fabsf(z), __builtin_amdgcn_logf(1.0f + t))); }
                        if (diag) {
#pragma unroll
                            for (int i = 0; i < 16; ++i) if (!(crow(i, h) < r)) sp[i] = 0.f; }
                        const float z0 = st[0];
                        f32x16 af = st;
#pragma unroll
                        for (int s = 0; s < 2; ++s) { h16x8 lf;
#pragma unroll
                            for (int j = 0; j < 8; ++j) lf[j] = (_Float16)(-sp[8 * s + j]);
                            af = __builtin_amdgcn_mfma_f32_32x32x16_f16(uf[s], lf, af, 0, 0, 0); }
#pragma unroll
                        for (int i = 0; i < 16; ++i) w[i] = __builtin_amdgcn_exp2f(af[i] + carry);
                        if (diag) {
#pragma unroll
                            for (int i = 0; i < 16; ++i) if (!(crow(i, h) < r)) w[i] = 0.f; }
                        const float c0 = af[0] - z0; const float cp = __shfl_xor(c0, 32); carry += h ? cp : c0;
                    } else {
                        const float ts = exp2f(lg * (float)(n0 - k0));
#pragma unroll
                        for (int i = 0; i < 16; ++i) w[i] = st[i] * (dl[i] * ts);
                        if (diag) {
#pragma unroll
                            for (int i = 0; i < 16; ++i) if (!(crow(i, h) <= r)) w[i] = 0.f; }
                    }
                    s16x8 pf[2];
#pragma unroll
                    for (int s = 0; s < 2; ++s) { v4u pw; pw.x = cvtpk_bf16(w[8 * s], w[8 * s + 1]); pw.y = cvtpk_bf16(w[8 * s + 2], w[8 * s + 3]); pw.z = cvtpk_bf16(w[8 * s + 4], w[8 * s + 5]); pw.w = cvtpk_bf16(w[8 * s + 6], w[8 * s + 7]); pf[s] = __builtin_bit_cast(s16x8, pw); }
                    const LAS unsigned char* vb = lds + AT_VS + buf * 64 * AT_VSTR + r * AT_VSTR + (32 * sub + 4 * h) * 2;
#pragma unroll
                    for (int s = 0; s < 2; ++s) {
                        const s16x4 a0 = *(const LAS s16x4*)(vb + 32 * s), a1 = *(const LAS s16x4*)(vb + 32 * s + 16);
                        const s16x4 b0 = *(const LAS s16x4*)(vb + 32 * AT_VSTR + 32 * s), b1 = *(const LAS s16x4*)(vb + 32 * AT_VSTR + 32 * s + 16);
                        const s16x8 v0 = __builtin_shufflevector(a0, a1, 0, 1, 2, 3, 4, 5, 6, 7), v1 = __builtin_shufflevector(b0, b1, 0, 1, 2, 3, 4, 5, 6, 7);
                        o0 = __builtin_amdgcn_mfma_f32_32x32x16_bf16(v0, pf[s], o0, 0, 0, 0); o1 = __builtin_amdgcn_mfma_f32_32x32x16_bf16(v1, pf[s], o1, 0, 0, 0); }
                }
            }
            if (MODE == 0 && __all(carry < -152.0f)) wdone = true;
        }
    };
    auto post = [&](int par) { if (MODE == 0 && lane == 0) flags[8 * par + wave] = wdone ? 1u : 0u; };
    auto all_done = [&](int par) -> bool { if (MODE != 0) return false; const v4u f0 = *(const LAS v4u*)(flags + 8 * par), f1 = *(const LAS v4u*)(flags + 8 * par + 4); return (f0.x & f0.y & f0.z & f0.w & f1.x & f1.y & f1.z & f1.w) != 0u; };
#define LBAR() do { asm volatile("s_waitcnt lgkmcnt(0)" ::: "memory"); __builtin_amdgcn_s_barrier(); asm volatile("" ::: "memory"); } while (0)
    for (int kt = kt_first; kt >= kt_lo + 1; kt -= 2) {
        if (kt - 2 >= kt_lo) stage_load(kt - 2, RB);
        compute(kt, 0);
        stage_store(1, RA);
        post(0);
        LBAR();
        if (all_done(0)) break;
        if (kt - 3 >= kt_lo) stage_load(kt - 3, RA);
        compute(kt - 1, 1);
        if (kt - 2 >= kt_lo) stage_store(0, RB);
        post(1);
        LBAR();
        if (all_done(1)) break;
    }
#undef LBAR
    bf16* yo = Y + (rowb + n0 + r) * DM + YCOL + hd * 64;
    if (MODE == 0) {
#pragma unroll
        for (int g = 0; g < 4; ++g) { v2u a; a.x = cvtpk_bf16(o0[4 * g], o0[4 * g + 1]); a.y = cvtpk_bf16(o0[4 * g + 2], o0[4 * g + 3]); *(v2u*)(yo + 8 * g + 4 * h) = a;
            v2u c; c.x = cvtpk_bf16(o1[4 * g], o1[4 * g + 1]); c.y = cvtpk_bf16(o1[4 * g + 2], o1[4 * g + 3]); *(v2u*)(yo + 32 + 8 * g + 4 * h) = c; }
    } else {
        float s = 0.f;
#pragma unroll
        for (int i = 0; i < 16; ++i) s += o0[i] + o1[i];
        s += __shfl_xor(s, 32); const float mu = s * (1.0f / 64.0f); float q2 = 0.f;
#pragma unroll
        for (int i = 0; i < 16; ++i) { const float e0 = o0[i] - mu, e1 = o1[i] - mu; q2 += e0 * e0 + e1 * e1; }
        q2 += __shfl_xor(q2, 32); const float rs = 1.0f / sqrtf(q2 * (1.0f / 64.0f) + 1e-6f);
        const bf16* gp = PROJ + (rowb + n0 + r) * INC + O_RET + 768 + hd * 64;
#pragma unroll
        for (int g = 0; g < 4; ++g)
#pragma unroll
            for (int db = 0; db < 2; ++db) { const int d = 32 * db + 8 * g + 4 * h; const v2u gv = *(const v2u*)(gp + d); const f32x4 gn = *(const f32x4*)(gain + hd * 64 + d);
                const float gg[4] = {bflo(gv.x), bfhi(gv.x), bflo(gv.y), bfhi(gv.y)}; float ov[4];
#pragma unroll
                for (int j = 0; j < 4; ++j) { const float x = db ? o1[4 * g + j] : o0[4 * g + j]; ov[j] = (x - mu) * rs * gn[j] * (gg[j] * __builtin_amdgcn_rcpf(1.0f + __expf(-gg[j]))); }
                v2u a; a.x = cvtpk_bf16(ov[0], ov[1]); a.y = cvtpk_bf16(ov[2], ov[3]); *(v2u*)(yo + d) = a; }
    }
    __syncthreads();
}

__device__ __forceinline__ void ret_state_unit(const bf16* PROJ, const float* ROPE, float* SLOC, unsigned* ctrA, int bh, int qb, LAS unsigned char* lds, int wave, int lane, int tid) {
    const int b = bh >> 2, hd = bh & 3, r = lane & 31, h = lane >> 5; const size_t rowb = (size_t)b * SEQ;
    const int st_row = (tid & 255) >> 2, st_c = tid & 3; const bool st_k = tid < 256;
    const float lg = log2f(1.0f - exp2f(-5.0f - (float)hd));
    v4u g0[4], g1[4]; f32x4 rp4[4][4];
#pragma unroll
    for (int t = 0; t < 4; ++t) { const int key = 256 * qb + 64 * t + st_row; const bf16* src = PROJ + (rowb + key) * INC + O_RET + (st_k ? 256 : 512) + hd * 64 + 8 * st_c; g0[t] = *(const v4u*)src; g1[t] = *(const v4u*)(src + 32);
        if (st_k) { const f32x4* rq = (const f32x4*)(ROPE + (size_t)key * 64 + 16 * st_c);
#pragma unroll
            for (int j = 0; j < 4; ++j) rp4[t][j] = rq[j]; } }
#pragma unroll
    for (int t = 0; t < 4; ++t) { const int jl = 64 * t + st_row;
        float a[8], c2[8]; unpack8(g0[t], a); unpack8(g1[t], c2);
        if (st_k) { const float zeta = exp2f(lg * (float)(255 - jl));
#pragma unroll
            for (int j = 0; j < 8; ++j) { const float cs = rp4[t][j >> 1][2 * (j & 1)], sn = rp4[t][j >> 1][2 * (j & 1) + 1]; const float x1 = a[j], x2 = c2[j]; a[j] = (x1 * cs - x2 * sn) * zeta; c2[j] = (x1 * sn + x2 * cs) * zeta; } }
        LAS unsigned short* d = (LAS unsigned short*)(lds + (st_k ? RS_KT : RS_VT) + (8 * st_c) * RS_STR + 2 * jl);
#pragma unroll
        for (int j = 0; j < 8; j += 2) { const unsigned p0 = cvtpk_bf16(a[j], a[j + 1]), p1 = cvtpk_bf16(c2[j], c2[j + 1]);
            d[j * (RS_STR / 2)] = (unsigned short)(p0 & 0xffffu); d[(j + 1) * (RS_STR / 2)] = (unsigned short)(p0 >> 16);
            d[(32 + j) * (RS_STR / 2)] = (unsigned short)(p1 & 0xffffu); d[(32 + j + 1) * (RS_STR / 2)] = (unsigned short)(p1 >> 16);
            if (j & 2) asm volatile("s_waitcnt lgkmcnt(0)" ::: "memory"); } }
    __syncthreads();
    if (wave < 4) { const int ba = wave >> 1, bb = wave & 1;
        f32x16 acc;
#pragma unroll
        for (int i = 0; i < 16; ++i) acc[i] = 0.f;
        const LAS unsigned char* va = lds + RS_VT + (32 * ba + r) * RS_STR + 16 * h; const LAS unsigned char* ka = lds + RS_KT + (32 * bb + r) * RS_STR + 16 * h;
#pragma unroll
        for (int s = 0; s < 16; ++s) { const s16x4 v0 = *(const LAS s16x4*)(va + 32 * s), v1 = *(const LAS s16x4*)(va + 32 * s + 8), k0 = *(const LAS s16x4*)(ka + 32 * s), k1 = *(const LAS s16x4*)(ka + 32 * s + 8);
            acc = __builtin_amdgcn_mfma_f32_32x32x16_bf16(__builtin_shufflevector(v0, v1, 0, 1, 2, 3, 4, 5, 6, 7), __builtin_shufflevector(k0, k1, 0, 1, 2, 3, 4, 5, 6, 7), acc, 0, 0, 0); }
        float* dst = SLOC + (size_t)(bh * 7 + qb) * 4096 + 32 * bb + r;
#pragma unroll
        for (int i = 0; i < 16; ++i) dst[(size_t)(32 * ba + crow(i, h)) * 64] = acc[i];
    }
    asm volatile("s_waitcnt vmcnt(0)" ::: "memory");
    __syncthreads();
    if (tid == 0) { __builtin_amdgcn_fence(__ATOMIC_RELEASE, "agent"); asm volatile("s_waitcnt vmcnt(0)" ::: "memory"); __hip_atomic_fetch_add(ctrA, 1u, __ATOMIC_RELAXED, __HIP_MEMORY_SCOPE_AGENT); }
    __syncthreads();
}


constexpr int S5_BUSTR = 132 * 4, S5_XSTR = 272, S5_WAVE = 16 * S5_BUSTR + 16 * S5_XSTR, S5_E = 8 * S5_WAVE;
__device__ __forceinline__ void s5_unit(KP p, int l, const bf16* PROJ, bf16* GBo, int bg, LAS unsigned char* lds, int wave, int lane) {
    const int b = bg >> 4, g = bg & 15, lq = lane >> 4, lr = lane & 15; const size_t rowb = (size_t)b * SEQ;
    const int gq = (l * 16 + g) * 64;
    const float dt = expf(((const float*)(GAS const float*)p->in[11])[l * 16 + g]);
    float are, aim;
    { const float lre = ((const float*)(GAS const float*)p->in[4])[gq + lane], lim = ((const float*)(GAS const float*)p->in[5])[gq + lane]; const float mag = expf(lre * dt); are = mag * cosf(lim * dt); aim = mag * sinf(lim * dt); }
    float pr = are, pi = aim;
#pragma unroll
    for (int k = 0; k < 8; ++k) { const float nr = pr * pr - pi * pi, ni = 2.0f * pr * pi; pr = nr; pi = ni; }
    s16x8 bbf[8];
#pragma unroll
    for (int q4 = 0; q4 < 4; ++q4) { const int pp = 16 * q4 + lr; const float lre = ((const float*)(GAS const float*)p->in[4])[gq + pp], lim = ((const float*)(GAS const float*)p->in[5])[gq + pp]; const float mag = expf(lre * dt), ar = mag * cosf(lim * dt), ai = mag * sinf(lim * dt);
        const float den = lre * lre + lim * lim, nr = ar - 1.0f, zre = (nr * lre + ai * lim) / den, zim = (ai * lre - nr * lim) / den;
        const float msk = lq < 2 ? 1.0f : 0.0f; const int hb = 8 * (lq & 1);
        const f32x4 r0 = *(const f32x4*)(((const float*)(GAS const float*)p->in[6]) + (size_t)(gq + pp) * 16 + hb), r1 = *(const f32x4*)(((const float*)(GAS const float*)p->in[6]) + (size_t)(gq + pp) * 16 + hb + 4);
        const f32x4 i0 = *(const f32x4*)(((const float*)(GAS const float*)p->in[7]) + (size_t)(gq + pp) * 16 + hb), i1 = *(const f32x4*)(((const float*)(GAS const float*)p->in[7]) + (size_t)(gq + pp) * 16 + hb + 4);
        float br[8] = {r0[0], r0[1], r0[2], r0[3], r1[0], r1[1], r1[2], r1[3]}, bi[8] = {i0[0], i0[1], i0[2], i0[3], i1[0], i1[1], i1[2], i1[3]}; float vr[8], vi[8];
#pragma unroll
        for (int j = 0; j < 8; ++j) { vr[j] = (zre * br[j] - zim * bi[j]) * msk; vi[j] = (zre * bi[j] + zim * br[j]) * msk; }
        v4u wr_, wi_; wr_.x = cvtpk_bf16(vr[0], vr[1]); wr_.y = cvtpk_bf16(vr[2], vr[3]); wr_.z = cvtpk_bf16(vr[4], vr[5]); wr_.w = cvtpk_bf16(vr[6], vr[7]);
        wi_.x = cvtpk_bf16(vi[0], vi[1]); wi_.y = cvtpk_bf16(vi[2], vi[3]); wi_.z = cvtpk_bf16(vi[4], vi[5]); wi_.w = cvtpk_bf16(vi[6], vi[7]);
        bbf[q4] = __builtin_bit_cast(s16x8, wr_); bbf[q4 + 4] = __builtin_bit_cast(s16x8, wi_); }
    s16x8 cf[4];
#pragma unroll
    for (int s = 0; s < 4; ++s) { const size_t co = ((size_t)(l * 16 + g) * 16 + lr) * 64 + 16 * s + 4 * lq;
        const f32x4 cr = *(const f32x4*)(((const float*)(GAS const float*)p->in[8]) + co), ci = *(const f32x4*)(((const float*)(GAS const float*)p->in[9]) + co);
        v4u w; w.x = cvtpk_bf16(cr[0], -ci[0]); w.y = cvtpk_bf16(cr[1], -ci[1]); w.z = cvtpk_bf16(cr[2], -ci[2]); w.w = cvtpk_bf16(cr[3], -ci[3]); cf[s] = __builtin_bit_cast(s16x8, w); }
    s16x8 dfrag;
    { const float dsk = ((const float*)(GAS const float*)p->in[10])[l * 256 + g * 16 + lr]; const unsigned short db = (unsigned short)f2bf(dsk);
#pragma unroll
      for (int j = 0; j < 8; ++j) dfrag[j] = (lq < 2 && 8 * lq + j == lr) ? (short)db : (short)0; }
    const bf16* usrc = PROJ + (rowb + 256 * wave + lr) * INC + g * 16 + 8 * (lq & 1);
    LAS float* BU = (LAS float*)(lds + wave * S5_WAVE); LAS unsigned char* XB = lds + wave * S5_WAVE + 16 * S5_BUSTR; LAS float* EB = (LAS float*)(lds + S5_E);
    const __amdgpu_buffer_rsrc_t gbrs = __builtin_amdgcn_make_buffer_rsrc((void*)GBo, 0, 0x7fffffff, 0x00020000);
    LAS unsigned char* SG = lds + (wave < 6 ? S5_E + 4096 + 4096 * wave : TAB_OFF + 4096 * (wave - 6));
    float xr = 0.f, xi = 0.f;
#define S5_LW() asm volatile("s_waitcnt lgkmcnt(0)" ::: "memory")
#define S5_TILE_HEAD() \
            v4u uw = uq0; uq0 = uq1; { const int tn = tile + 2 < 16 ? tile + 2 : 15; uq1 = *(const v4u*)(usrc + (size_t)(16 * tn) * INC); } \
            if (lq >= 2) { uw.x = 0u; uw.y = 0u; uw.z = 0u; uw.w = 0u; } \
            const s16x8 uf = __builtin_bit_cast(s16x8, uw); \
            _Pragma("unroll") for (int cb = 0; cb < 8; ++cb) { f32x4 acc = {0.f, 0.f, 0.f, 0.f}; acc = __builtin_amdgcn_mfma_f32_16x16x32_bf16(uf, bbf[cb], acc, 0, 0, 0); \
                _Pragma("unroll") for (int rg = 0; rg < 4; ++rg) BU[(4 * lq + rg) * 132 + 16 * cb + lr] = acc[rg]; \
                if ((cb & 3) == 3) S5_LW(); } \
            float bur[16], bui[16]; \
            _Pragma("unroll") for (int tt = 0; tt < 16; ++tt) { bur[tt] = BU[tt * 132 + lane]; bui[tt] = BU[tt * 132 + 64 + lane]; if ((tt & 7) == 7) S5_LW(); }
    { v4u uq0 = *(const v4u*)usrc, uq1 = *(const v4u*)(usrc + (size_t)16 * INC);
#pragma unroll 1
      for (int tile = 0; tile < 16; ++tile) {
            S5_TILE_HEAD()
#pragma unroll
            for (int tt = 0; tt < 16; ++tt) { const float nxr = are * xr - aim * xi + bur[tt], nxi = are * xi + aim * xr + bui[tt]; xr = nxr; xi = nxi; }
      } }
    { EB[wave * 128 + lane] = xr; EB[wave * 128 + 64 + lane] = xi;
      __syncthreads();
      float cr = 0.f, ci = 0.f;
      for (int w2 = 0; w2 < wave; ++w2) { const float er = EB[w2 * 128 + lane], ei = EB[w2 * 128 + 64 + lane]; const float nr = pr * cr - pi * ci + er, ni = pr * ci + pi * cr + ei; cr = nr; ci = ni; }
      xr = cr; xi = ci; }
    { v4u uq0 = *(const v4u*)usrc, uq1 = *(const v4u*)(usrc + (size_t)16 * INC);
#pragma unroll 1
      for (int tile = 0; tile < 16; ++tile) {
            S5_TILE_HEAD()
#pragma unroll
            for (int tt = 0; tt < 16; ++tt) { const float nxr = are * xr - aim * xi + bur[tt], nxi = are * xi + aim * xr + bui[tt]; xr = nxr; xi = nxi;
                *(LAS unsigned*)(XB + tt * S5_XSTR + 4 * lane) = cvtpk_bf16(xr, xi); if ((tt & 7) == 7) S5_LW(); }
            f32x4 ya = {0.f, 0.f, 0.f, 0.f};
#pragma unroll
            for (int s = 0; s < 4; ++s) { const s16x8 xa = *(const LAS s16x8*)(XB + lr * S5_XSTR + (32 * s + 8 * lq) * 2); ya = __builtin_amdgcn_mfma_f32_16x16x32_bf16(xa, cf[s], ya, 0, 0, 0); }
            ya = __builtin_amdgcn_mfma_f32_16x16x32_bf16(uf, dfrag, ya, 0, 0, 0);
#pragma unroll
            for (int rg = 0; rg < 4; ++rg) { const float y = ya[rg];
                const float gl = y * __builtin_amdgcn_rcpf(1.0f + __expf(-1.5957691216057308f * (y + 0.044715f * y * y * y)));
                *(LAS unsigned short*)(SG + (((tile & 7) * 16 + 4 * lq + rg) * 16 + lr) * 2) = (unsigned short)f2bf(gl); }
            if ((tile & 7) == 7) {
#pragma unroll
                for (int j = 0; j < 4; ++j) { const int c = lane + 64 * j, r = c >> 1, hf = c & 1; const v4u v = *(const LAS v4u*)(SG + r * 32 + hf * 16);
                    __builtin_amdgcn_raw_buffer_store_b128(v, gbrs, (int)(((rowb + 256 * wave + 128 * (tile >> 3) + r) * 256 + g * 16 + hf * 8) * 2), 0, 16); }
            }
      } }
#undef S5_TILE_HEAD
#undef S5_LW
    __syncthreads();
}

__global__ void __launch_bounds__(512, 2) mk_fwd(P p_arg) {
    extern __shared__ __attribute__((aligned(16))) unsigned char lds_raw[];
    LAS unsigned char* lds = (LAS unsigned char*)lds_raw;
    const int tid0 = threadIdx.x, G0 = gridDim.x, bid0 = blockIdx.x, wave0 = __builtin_amdgcn_readfirstlane(tid0 >> 6);
    const KP kp0 = (KP)__builtin_amdgcn_kernarg_segment_ptr();
    volatile LAS unsigned* MISC = (volatile LAS unsigned*)(lds + MISC_OFF);
    if (tid0 < 32) MISC[tid0] = 0u;
    __syncthreads();
#if !MK_MULTI
    XcdBarrier bar = xcd_barrier_post((unsigned*)(kp0->ws + WS_CTL), MISC + 8);
#define SEAM(k) do { if (hi > (k) + 1) xcd_barrier(bar); } while (0)
#else
#define SEAM(k) do { } while (0)
#endif
    const int lo = kp0->ph_lo, hi = kp0->ph_hi;
#define IN(k) (lo <= (k) && (k) < hi)
#define GIN(k_) ((const float*)(GAS const float*)p->in[k_])
#define PH_BEGIN KP p = kp0; asm volatile("" : "+s"(p)); GAS unsigned char* ws = (GAS unsigned char*)p->ws; asm volatile("" : "+s"(ws)); \
    int G = G0, bid = bid0, wave = wave0; asm volatile("" : "+s"(G), "+s"(bid), "+s"(wave)); \
    unsigned ones_ = ~0u; asm volatile("" : "+s"(ones_)); const int lane = (int)__builtin_amdgcn_mbcnt_hi(ones_, __builtin_amdgcn_mbcnt_lo(ones_, 0u)), tid = wave * 64 + lane, gw = bid * 8 + wave, NGW = G * 8; (void)tid; (void)gw; (void)NGW;
#define H ((bf16*)(ws + WS_H))
#define SSQ ((float*)(ws + WS_SSQ))
#define ROPE ((const float*)(ws + WS_ROPE))
#define MEMN ((bf16*)(ws + WS_MEMN))
#define KC ((bf16*)(ws + WS_KC))
#define VT ((bf16*)(ws + WS_VT))
#define PROJ ((bf16*)(ws + AR_PROJ))
#define Y ((bf16*)(ws + AR_Y))
#define GB ((bf16*)(ws + AR_G))
#define ZB ((bf16*)(ws + AR_Z))
#define XS ((float*)(ws + AR_XS))
#define QC ((bf16*)(ws + AR_QC))
#define SC ((float*)(ws + AR_SC))
#define PB ((bf16*)(ws + AR_PB))
#define OC ((bf16*)(ws + AR_OC))
#define ACT ((bf16*)(ws + AR_ACT))
#define XG ((bf16*)(ws + AR_XG))
#define ACTG ((bf16*)(ws + AR_ACTG))
#define DG ((bf16*)(ws + AR_DG))
#define CNT ((int*)(ws + WS_MOEI + MI_CNT))
#define EST ((int*)(ws + WS_MOEI + MI_EST))
#define TOPI ((int*)(ws + WS_MOEI + MI_TOPI))
#define TOPG ((float*)(ws + WS_MOEI + MI_TOPG))
#define RSTD ((float*)(ws + WS_MOEI + MI_RSTD))
#define POS ((int*)(ws + WS_MOEI + MI_POS))
#define RSTDG ((float*)(ws + WS_MOEI + MI_RSTDG))

    if (IN(0)) { PH_BEGIN phase_prologue(p, ws, lds, bid, G, gw, NGW, wave, lane, tid); SEAM(0); }
    if (IN(1)) { PH_BEGIN
        { pg8::Gemm g{MEMN, (const bf16*)(ws + WS_WCK), DM, DM, DM}; pg8::Order S; S.init(MROWS / 256, 4 * DM / 256, G, bid); S.plain(DM, DM);
          pg8::EpiBf16 E{KC, 4 * DM}; pg8::gemm_phase<pg8::EpiBf16, pg8::Order, true, true>(lds, g, S, E, wave); }
        { pg8::Gemm g{MEMN, (const bf16*)(ws + WS_WCV), DM, DM, DM}; pg8::Order S; S.init(MROWS / 256, 4 * DM / 256, G, bid); S.plain(DM, DM);
          pg8::EpiBf16 E{VT, 4 * DM}; pg8::gemm_phase<pg8::EpiBf16, pg8::Order, true, true>(lds, g, S, E, wave); }
        SEAM(1);
    }
    for (int l = 0; l < NL; ++l) {
        const int pb = 3 + 16 * l;
        if (IN(pb + 0)) { PH_BEGIN
            { pg8::Gemm g{(const bf16*)(ws + AR_Y), (const bf16*)(ws + WS_Q8IN + (size_t)l * INC * DM), DM / 2, DM / 2, DM / 2}; pg8::Order S; S.init(T / 256, INC / 256, G, bid); S.plain(DM / 2, DM / 2);
              pg8::EpiScaleI8 E{PROJ, INC, (const float*)(ws + WS_MOEI + MI_RSC0), (const float*)(ws + WS_Q8INS) + (size_t)l * INC, (LAS float*)(lds + TAB_OFF)}; pg8::gemm_phase<pg8::EpiScaleI8, pg8::Order, true, true, true>(lds, g, S, E, wave); }
            { const bool up = bid >= G / 2; const int hc = up ? bid - G / 2 : bid, hg = G / 2;
              if (up) { pg8::Gemm g{KC, (const bf16*)(ws + WS_WCQ), 256, 4 * DM, DM}; pg8::Order S; S.init(64, 4, hg, hc); S.mode = 1; S.lyr = l;
                  pg8::EpiBf16 E{(bf16*)(ws + WS_WK), DM}; pg8::gemm_phase<pg8::EpiBf16, pg8::Order, true, true>(lds, g, S, E, wave); }
              { pg8::Gemm g{(const bf16*)(ws + WS_WCO), VT, 256, DM, 4 * DM}; pg8::Order S; S.init(64, 4, hg, hc); S.mode = 2; S.lyr = l; if (up) S.uend = 128; else S.u0 = 128;
                  pg8::EpiBf16 E{(bf16*)(ws + WS_VO), DM}; pg8::gemm_phase<pg8::EpiBf16, pg8::Order, true, true>(lds, g, S, E, wave); } }
            SEAM(pb + 0);
        }
        if (IN(pb + 1)) { PH_BEGIN
            unsigned* ctr = (unsigned*)(ws + WS_CTL + 16384 + 256 * l); unsigned* ctrA = (unsigned*)(ws + WS_CTL + 24576 + 256 * l); float* SLOC = (float*)(ws + AR_XS);
            for (;;) {
                __syncthreads();
                if (tid == 0) *(LAS unsigned*)(lds + AT_UNIT) = __hip_atomic_fetch_add(ctr, 1u, __ATOMIC_RELAXED, __HIP_MEMORY_SCOPE_AGENT);
                __syncthreads();
                const int u = __builtin_amdgcn_readfirstlane(*(LAS unsigned*)(lds + AT_UNIT));
                if (u >= 448 + 256 + 1024 + 512) break;
                int lane_u = lane; asm volatile("" : "+v"(lane_u)); const int tid_u = wave * 64 + lane_u;
                if (u < 448) ret_state_unit(PROJ, ROPE, SLOC, ctrA, u / 7, u % 7, lds, wave, lane_u, tid_u);
                else if (u < 704) s5_unit(p, l, PROJ, GB, u - 448, lds, wave, lane_u);
                else if (u < 1728) { const int v = u - 704; attn_unit<0>(PROJ, Y, ROPE, nullptr, nullptr, nullptr, v & 127, 7 - (v >> 7), lds, wave, lane_u, tid_u); }
                else { const int v = u - 1728; attn_unit<1>(PROJ, Y, ROPE, GIN(13) + l * DM + 256, SLOC, ctrA, v & 63, 7 - (v >> 6), lds, wave, lane_u, tid_u); }
            }
            SEAM(pb + 1);
        }
        if (IN(pb + 3)) { PH_BEGIN
            const float* gain = GIN(13) + l * DM;
            { pg8::Gemm g{GB, (const bf16*)(ws + WS_WGLU) + (size_t)l * 256 * 256, 256, 256, 256}; pg8::Order S; S.init(T / 256, 1, G, bid); S.plain(256, 256);
              pg8::EpiGlu E{GB, Y, DM, gain, (LAS float*)(lds + TAB_OFF)}; pg8::gemm_phase<pg8::EpiGlu, pg8::Order, true, true>(lds, g, S, E, wave); }
            for (int m = gw; m < T; m += NGW) {
                v4u* yp = (v4u*)(Y + (size_t)m * DM + 512) + lane; const v4u yv = *yp; float a[8]; unpack8(yv, a); float s = 0.f;
#pragma unroll
                for (int j = 0; j < 8; ++j) s += a[j] * a[j];
                const float rs = 1.0f / sqrtf(wave_sum(s) * (1.0f / 512.0f) + NORM_EPS); const f32x4 g0 = ((const f32x4*)(gain + 512))[2 * lane], g1 = ((const f32x4*)(gain + 512))[2 * lane + 1];
                v4u o; o.x = pk2(a[0] * rs * g0[0], a[1] * rs * g0[1]); o.y = pk2(a[2] * rs * g0[2], a[3] * rs * g0[3]); o.z = pk2(a[4] * rs * g1[0], a[5] * rs * g1[1]); o.w = pk2(a[6] * rs * g1[2], a[7] * rs * g1[3]); *yp = o; }
            SEAM(pb + 3);
        }
        if (IN(pb + 5)) { PH_BEGIN
            pg8::Gemm g{Y, (const bf16*)(ws + WS_WOUT) + (size_t)l * DM * DM, DM, DM, DM}; pg8::Order S; S.init(T / 256, DM / 256, G, bid); S.plain(DM, DM);
            pg8::EpiRes E{H, SSQ}; pg8::gemm_phase<pg8::EpiRes, pg8::Order, true, true>(lds, g, S, E, wave);
            SEAM(pb + 5);
        }
        if (IN(pb + 6)) { PH_BEGIN
            pg8::Gemm g{H, (const bf16*)(ws + WS_WK), DM, DM, DM}; pg8::Order S; S.init(T / 256, 4, G, bid);
            S.a_pm = 256L * DM * 2; S.b_pn = 256L * DM * 2; S.b_pb = (long)DM * DM * 2;
            pg8::EpiSoftmax E{PB, DM, (LAS float*)(lds + TAB_OFF), SSQ}; pg8::gemm_phase<pg8::EpiSoftmax, pg8::Order, true, true>(lds, g, S, E, wave);
            SEAM(pb + 6);
        }
        if (IN(pb + 7)) { PH_BEGIN
            pg8::Gemm g{PB, (const bf16*)(ws + WS_VO), DM, DM, DM}; pg8::Order S; S.init(T / 256, 4, G, bid);
            S.a_pm = 256L * DM * 2; S.b_pn = 256L * DM * 2; S.b_pb = (long)DM * DM * 2;
            pg8::EpiRes E{H, SSQ}; pg8::gemm_phase<pg8::EpiRes, pg8::Order, true, true>(lds, g, S, E, wave);
            SEAM(pb + 7);
        }
        if ((l & 1) == 0) {
            if (IN(pb + 8)) { PH_BEGIN
                unsigned char* HQ = (unsigned char*)(ws + AR_Y);
                for (int m = gw; m < T; m += NGW) { float a[8], b2[8]; unpack8(((const v4u*)(H + (size_t)m * DM))[lane], a); unpack8(((const v4u*)(H + (size_t)m * DM + 512))[lane], b2);
                    const float mx = absmax16(a, b2), step = mx > 0.f ? mx * (1.0f / 127.0f) : 1.0f, inv = 1.0f / step;
                    ((v2u*)(HQ + (size_t)m * DM))[lane] = q8_pack8(a, inv); ((v2u*)(HQ + (size_t)m * DM + 512))[lane] = q8_pack8(b2, inv);
                    if (lane == 0) RSTD[m] = step * rstd16(SSQ, m); }
                SEAM(pb + 8);
            }
            if (IN(pb + 11)) { PH_BEGIN
                pg8::Gemm g{(const bf16*)(ws + AR_Y), (const bf16*)(ws + WS_Q8W + (size_t)(l >> 1) * 2 * FF * DM), DM / 2, DM / 2, DM / 2}; pg8::Order S; S.init(T / 256, 2 * FF / 256, G, bid); S.plain(DM / 2, DM / 2);
                pg8::EpiSwigluI8 E{ACT, FF, RSTD, (const float*)(ws + WS_Q8S) + (size_t)(l >> 1) * 2 * FF, 0, (LAS float*)(lds + TAB_OFF)}; pg8::gemm_phase<pg8::EpiSwigluI8, pg8::Order, true, true, true>(lds, g, S, E, wave);
                SEAM(pb + 11);
            }
            if (IN(pb + 12)) { PH_BEGIN
                pg8::Gemm g{ACT, (const bf16*)(ws + WS_WDDN) + (size_t)(l >> 1) * DM * FF, FF, FF, FF}; pg8::Order S; S.init(T / 256, DM / 256, G, bid); S.plain(FF, FF);
                pg8::EpiRes E{H, SSQ}; pg8::gemm_phase<pg8::EpiRes, pg8::Order, true, true>(lds, g, S, E, wave);
                SEAM(pb + 12);
            }
            if (IN(pb + 13)) { PH_BEGIN
                unsigned char* HQ = (unsigned char*)(ws + AR_Y); float* RSC0 = (float*)(ws + WS_MOEI + MI_RSC0);
                for (int m = gw; m < T; m += NGW) { float a[8], b2[8]; unpack8(((const v4u*)(H + (size_t)m * DM))[lane], a); unpack8(((const v4u*)(H + (size_t)m * DM + 512))[lane], b2);
                    const float mx = absmax16(a, b2), step = mx > 0.f ? mx * (1.0f / 127.0f) : 1.0f, inv = 1.0f / step;
                    ((v2u*)(HQ + (size_t)m * DM))[lane] = q8_pack8(a, inv); ((v2u*)(HQ + (size_t)m * DM + 512))[lane] = q8_pack8(b2, inv);
                    if (lane == 0) RSC0[m] = step * rstd16(SSQ, m); }
                SEAM(pb + 13);
            }
        } else {
            if (IN(pb + 11)) { PH_BEGIN
                LAS int* hist = (LAS int*)lds; LAS float* lgs = (LAS float*)(lds + 64) + wave * 128; if (tid < 8) hist[tid] = 0; __syncthreads();
                const float* WRl = (const float*)(ws + WS_WR) + (size_t)(l >> 1) * DM * NEXP;
                const int tok0 = bid * 128 + wave * 16, lr = lane & 15, lq = lane >> 4;
                f32x4 acc = {0.f, 0.f, 0.f, 0.f};
                const bf16* hp = H + (size_t)(tok0 + lr) * DM + 8 * lq; const float* wp = WRl + (size_t)(8 * lq) * 8 + (lr & 7); const float bm = lr < 8 ? 1.0f : 0.0f;
#pragma unroll 2
                for (int s2 = 0; s2 < 32; ++s2) { float a[8]; unpack8(*(const v4u*)(hp + 32 * s2), a);
#pragma unroll
                    for (int j = 0; j < 8; ++j) acc = __builtin_amdgcn_mfma_f32_16x16x4f32(a[j], wp[(size_t)(32 * s2 + j) * 8] * bm, acc, 0, 0, 0); }
                if (lr < 8) {
#pragma unroll
                    for (int rg = 0; rg < 4; ++rg) lgs[(4 * lq + rg) * 8 + lr] = acc[rg]; }
                asm volatile("s_waitcnt lgkmcnt(0)" ::: "memory");
                if (lane < 16) { const int row = tok0 + lane; const float rs = rstd16(SSQ, row); const f32x4 l0 = *(const LAS f32x4*)(lgs + lane * 8), l1 = *(const LAS f32x4*)(lgs + lane * 8 + 4);
                    const float lg[8] = {l0[0] * rs, l0[1] * rs, l0[2] * rs, l0[3] * rs, l1[0] * rs, l1[1] * rs, l1[2] * rs, l1[3] * rs};
                    float v1 = lg[0]; int i1 = 0;
#pragma unroll
                    for (int e = 1; e < 8; ++e) if (lg[e] > v1) { v1 = lg[e]; i1 = e; }
                    float v2 = -3.0e38f; int i2 = -1;
#pragma unroll
                    for (int e = 0; e < 8; ++e) if (e != i1 && lg[e] > v2) { v2 = lg[e]; i2 = e; }
                    const float g2 = 1.0f / (1.0f + expf(v1 - v2)), g1 = 1.0f - g2;
                    TOPI[2 * row] = i1; TOPI[2 * row + 1] = i2; TOPG[2 * row] = g1; TOPG[2 * row + 1] = g2; RSTD[row] = rs;
                    __hip_atomic_fetch_add(&hist[i1], 1, __ATOMIC_RELAXED, __HIP_MEMORY_SCOPE_WORKGROUP); __hip_atomic_fetch_add(&hist[i2], 1, __ATOMIC_RELAXED, __HIP_MEMORY_SCOPE_WORKGROUP); }
                __syncthreads(); if (tid < 8) CNT[bid * 8 + tid] = hist[tid];
                SEAM(pb + 11);
            }
            if (IN(pb + 12)) { PH_BEGIN
                unsigned char* XQ = (unsigned char*)(ws + AR_XG);
                LAS int* sh = (LAS int*)lds;
                if (tid < 16) sh[tid] = 0;
                __syncthreads();
                { const int4 c = ((const int4*)CNT)[tid]; const int w = tid >> 1, e0 = 4 * (tid & 1); const int cc[4] = {c.x, c.y, c.z, c.w};
#pragma unroll
                  for (int i = 0; i < 4; ++i) { __hip_atomic_fetch_add(&sh[e0 + i], cc[i], __ATOMIC_RELAXED, __HIP_MEMORY_SCOPE_WORKGROUP); if (w < bid) __hip_atomic_fetch_add(&sh[8 + e0 + i], cc[i], __ATOMIC_RELAXED, __HIP_MEMORY_SCOPE_WORKGROUP); } }
                int myexp = 0; if (tid < 256) { myexp = TOPI[(size_t)bid * 256 + tid]; sh[320 + tid] = myexp; }
                __syncthreads();
                if (tid == 0) { int s = 0; for (int e = 0; e < 8; ++e) { sh[16 + e] = s; sh[32 + e] = s + sh[8 + e]; s += (sh[e] + 255) & ~255; } sh[24] = s;
                    if (bid == 0) for (int e = 0; e < 9; ++e) EST[e] = sh[16 + e]; }
                int rank = 0;
                if (tid < 256) {
#pragma unroll
                    for (int e = 0; e < 8; ++e) { const unsigned long long m = __builtin_amdgcn_ballot_w64(myexp == e); if (myexp == e) rank = __builtin_popcountll(m & ((1ull << lane) - 1ull)); if (lane == 0) sh[576 + wave * 8 + e] = __builtin_popcountll(m); } }
                __syncthreads();
                if (tid < 256) { int pos = sh[32 + myexp] + rank; for (int w2 = 0; w2 < wave; ++w2) pos += sh[576 + w2 * 8 + myexp]; sh[64 + tid] = pos; }
                __syncthreads();
#pragma unroll 1
                for (int k4 = 0; k4 < 4; ++k4) { v4u a[4], b2[4]; float rs[4];
#pragma unroll
                    for (int q = 0; q < 4; ++q) { const int row = bid * 128 + wave * 16 + 4 * k4 + q; a[q] = ((const v4u*)(H + (size_t)row * DM))[lane]; b2[q] = ((const v4u*)(H + (size_t)row * DM + 512))[lane]; rs[q] = RSTD[row]; }
#pragma unroll
                    for (int q = 0; q < 4; ++q) { const int k = wave * 16 + 4 * k4 + q, row = bid * 128 + k;
                        float fa[8], fb[8]; unpack8(a[q], fa); unpack8(b2[q], fb);
                        const float mx = absmax16(fa, fb), step = mx > 0.f ? mx * (1.0f / 127.0f) : 1.0f, inv = 1.0f / step; const v2u qa = q8_pack8(fa, inv), qb = q8_pack8(fb, inv);
#pragma unroll
                        for (int sl = 0; sl < 2; ++sl) { const int pos = sh[64 + 2 * k + sl]; ((v2u*)(XQ + (size_t)pos * DM))[lane] = qa; ((v2u*)(XQ + (size_t)pos * DM + 512))[lane] = qb;
                            if (lane == 0) { RSTDG[pos] = rs[q] * step; POS[2 * row + sl] = pos; } } } }
                { const int e = bid & 7, i = (bid >> 3) * 8 + wave, pos = sh[16 + e] + sh[e] + i;
                  if (pos < sh[16 + e + 1]) { unsigned zz = 0u; asm volatile("" : "+v"(zz)); const v4u z = {zz, zz, zz, zz}; ((v4u*)(XQ + (size_t)pos * DM))[lane] = z; if (lane == 0) RSTDG[pos] = 0.f; } }
                SEAM(pb + 12);
            }
            if (IN(pb + 13)) { PH_BEGIN
                const int nM = __builtin_amdgcn_readfirstlane(EST[8]) / 256;
                pg8::Gemm g{(const bf16*)(ws + AR_XG), (const bf16*)(ws + WS_Q8W + (size_t)(2 + (l >> 1) * NEXP) * 2 * FF * DM), DM / 2, DM / 2, DM / 2}; pg8::Order S; S.init(nM, 2 * FF / 256, G, bid); S.plain(DM / 2, DM / 2);
                S.experts(EST); S.b_e = (long)2 * FF * DM;
                pg8::EpiSwigluI8 E{ACTG, FF, RSTDG, (const float*)(ws + WS_Q8S) + (size_t)(2 + (l >> 1) * NEXP) * 2 * FF, 2 * FF, (LAS float*)(lds + TAB_OFF)}; pg8::gemm_phase<pg8::EpiSwigluI8, pg8::Order, true, true, true>(lds, g, S, E, wave);
                SEAM(pb + 13);
            }
            if (IN(pb + 14)) { PH_BEGIN
                const int nM = __builtin_amdgcn_readfirstlane(EST[8]) / 256, nMain = nM < 256 ? nM : 256, nOv = nM - nMain;
                { pg8::Gemm g{ACTG, (const bf16*)(ws + WS_WEDN) + (size_t)(l >> 1) * NEXP * DM * FF, FF, FF, FF}; pg8::Order S; S.init(nMain, DM / 256, G, bid); S.plain(FF, FF);
                  S.experts(EST); S.b_e = (long)DM * FF * 2;
                  pg8::EpiBf16 E{DG, DM}; pg8::gemm_phase<pg8::EpiBf16, pg8::Order, true, true>(lds, g, S, E, wave); }
                if (nOv > 0) { pg8::Gemm g{ACTG, (const bf16*)(ws + WS_WEDN) + (size_t)(l >> 1) * NEXP * DM * FF, 256, FF, FF}; pg8::Order S; S.init(nOv * 11, DM / 256, G, bid); S.mode = 3; S.experts(EST);
                  pg8::EpiF32 E{(float*)(ws + AR_XG), DM}; pg8::gemm_phase<pg8::EpiF32, pg8::Order, true, true>(lds, g, S, E, wave); }
                SEAM(pb + 14);
            }
            if (IN(pb + 15)) { PH_BEGIN
                const bool last = (l == NL - 1); const float* fw = GIN(26); float* outp = ((float*)(GAS float*)p->out);
                for (int m = gw; m < T; m += NGW) { const int p0 = POS[2 * m], p1 = POS[2 * m + 1]; const float g0 = TOPG[2 * m], g1 = TOPG[2 * m + 1]; float s = 0.f; float hv[2][8];
#pragma unroll
                    for (int hf = 0; hf < 2; ++hf) { v4u* hp = (v4u*)(H + (size_t)m * DM + 512 * hf) + lane; float a[8], d0[8], d1[8]; unpack8(*hp, a);
                        auto ldrow = [&](int pp, float* d) { if (pp < 65536) { unpack8(((const v4u*)(DG + (size_t)pp * DM + 512 * hf))[lane], d); }
                            else { const int ov = pp - 65536, pmo = ov >> 8, rr = ov & 255; const float* base = (const float*)(ws + AR_XG) + ((size_t)(pmo * 11) * 256 + rr) * DM + 512 * hf + 8 * lane;
#pragma unroll
                                for (int j = 0; j < 8; ++j) d[j] = 0.f;
                                for (int ks = 0; ks < 11; ++ks) { const f32x4 q0 = *(const f32x4*)(base + (size_t)ks * 256 * DM), q1 = *(const f32x4*)(base + (size_t)ks * 256 * DM + 4);
#pragma unroll
                                    for (int j = 0; j < 4; ++j) { d[j] += q0[j]; d[4 + j] += q1[j]; } } } };
                        ldrow(p0, d0); ldrow(p1, d1);
#pragma unroll
                        for (int j = 0; j < 8; ++j) a[j] += g0 * d0[j] + g1 * d1[j];
                        v4u o; o.x = pk2(a[0], a[1]); o.y = pk2(a[2], a[3]); o.z = pk2(a[4], a[5]); o.w = pk2(a[6], a[7]); if (!last) *hp = o;
                        unpack8(o, hv[hf]);
#pragma unroll
                        for (int j = 0; j < 8; ++j) s += hv[hf][j] * hv[hf][j]; }
                    s = wave_sum(s);
                    if (!last) { if (lane < 16) SSQ[(size_t)m * 16 + lane] = lane == 0 ? s : 0.f;
                        float mx = 0.f;
#pragma unroll
                        for (int hf = 0; hf < 2; ++hf)
#pragma unroll
                            for (int j = 0; j < 8; ++j) mx = fmaxf(mx, fabsf(hv[hf][j]));
                        mx = wave_max(mx); const float step = mx > 0.f ? mx * (1.0f / 127.0f) : 1.0f, inv = 1.0f / step;
                        ((v2u*)((unsigned char*)(ws + AR_Y) + (size_t)m * DM))[lane] = q8_pack8(hv[0], inv); ((v2u*)((unsigned char*)(ws + AR_Y) + (size_t)m * DM + 512))[lane] = q8_pack8(hv[1], inv);
                        if (lane == 0) ((float*)(ws + WS_MOEI + MI_RSC0))[m] = step / sqrtf(s * (1.0f / DM) + NORM_EPS); }
                    else { const float rs = 1.0f / sqrtf(s * (1.0f / DM) + NORM_EPS);
#pragma unroll
                        for (int hf = 0; hf < 2; ++hf) { const f32x4 w0 = ((const f32x4*)(fw + 512 * hf))[2 * lane], w1 = ((const f32x4*)(fw + 512 * hf))[2 * lane + 1];
                            f32x4 o0 = {hv[hf][0] * rs * w0[0], hv[hf][1] * rs * w0[1], hv[hf][2] * rs * w0[2], hv[hf][3] * rs * w0[3]}, o1 = {hv[hf][4] * rs * w1[0], hv[hf][5] * rs * w1[1], hv[hf][6] * rs * w1[2], hv[hf][7] * rs * w1[3]};
                            f32x4* op = (f32x4*)(outp + (size_t)m * DM + 512 * hf) + 2 * lane; op[0] = o0; op[1] = o1; } } }
                SEAM(pb + 15);
            }
        }
    }
#undef IN
#undef SEAM
}

extern "C" void kernel_launch(void* const* d_in, const int* in_sizes, int n_in, void* d_out, int out_size, void* d_ws, size_t ws_size, hipStream_t stream) {
    static int grid = 0;
    if (grid == 0) {
        if (n_in != 27 || in_sizes[0] != T * DM || out_size != T * DM || ws_size < WS_END) { fprintf(stderr, "kernel_launch: unexpected problem (n_in %d, in0 %d, out %d, ws %zu < %zu); nothing launched\n", n_in, n_in > 0 ? in_sizes[0] : -1, out_size, ws_size, (size_t)WS_END); grid = -1; return; }
        int dev = 0, cus = 0;
        if (hipGetDevice(&dev) != hipSuccess || hipDeviceGetAttribute(&cus, hipDeviceAttributeMultiprocessorCount, dev) != hipSuccess) { fprintf(stderr, "kernel_launch: device query failed\n"); grid = -1; return; }
        if (hipFuncSetAttribute((const void*)mk_fwd, hipFuncAttributeMaxDynamicSharedMemorySize, LDS_BYTES) != hipSuccess) { fprintf(stderr, "kernel_launch: hipFuncSetAttribute failed\n"); grid = -1; return; }
        int per_cu = 0; (void)hipOccupancyMaxActiveBlocksPerMultiprocessor(&per_cu, (const void*)mk_fwd, 512, LDS_BYTES); (void)hipGetLastError();
        if (cus != 256 || per_cu < 1) { fprintf(stderr, "kernel_launch: needs 256 CUs with one resident workgroup each (cus %d, per_cu %d)\n", cus, per_cu); grid = -1; return; }
        grid = 256;
    }
    if (grid < 0) return;
    (void)hipMemsetAsync((char*)d_ws + WS_CTL, 0, 32768, stream);
    P a{};
    for (int i = 0; i < 27; ++i) a.in[i] = (const float*)d_in[i];
    a.out = (float*)d_out; a.ws = (unsigned char*)d_ws;
    constexpr int NPH = 3 + 16 * NL;
#if MK_MULTI
    for (int ph = 0; ph < NPH; ++ph) {
        if (ph >= 3 && ph < 3 + 16 * NL) { const int l = (ph - 3) / 16, k = (ph - 3) % 16; if ((l & 1) == 0 && k > 13) continue; }
        a.ph_lo = ph; a.ph_hi = ph + 1;
        hipLaunchKernelGGL(mk_fwd, dim3(grid), dim3(512), LDS_BYTES, stream, a);
    }
#else
    a.ph_lo = 0; a.ph_hi = NPH;
    hipLaunchKernelGGL(mk_fwd, dim3(grid), dim3(512), LDS_BYTES, stream, a);
#endif
}
```
